# Optimizing an MI355X kernel written in HIP

```python
import math
import jax, jax.numpy as jnp
from jax import lax
import numpy as np

D_MODEL = 1024
BATCH = 8
SEQ = 4096
DEPTH = 4

N_MIXERS = 2
N_DIFF_LAYERS = (DEPTH + 1) // 2
N_SWA_LAYERS = DEPTH // 2

DIFF_HEADS = 8
DIFF_HEAD_DIM = D_MODEL // DIFF_HEADS // 2
DIFF_Q_BLOCK = 128

SWA_Q_HEADS = 16
SWA_KV_HEADS = 4
SWA_GROUP = SWA_Q_HEADS // SWA_KV_HEADS
SWA_HEAD_DIM = D_MODEL // SWA_Q_HEADS
WINDOW = 128
SWA_BLOCK = WINDOW

ROPE_DIM = 64
ROPE_THETA = 10000.0

D_FF = 2816
CONV_WIDTH = 3
PLE_DIM = 256
EPS = 1e-6

kernel_name = "hybrid_diffattn_swa_convffn_ple_encoder"


def rms_norm(x, g):
    xf = x.astype(jnp.float32)
    y = xf * lax.rsqrt(jnp.mean(xf * xf, axis=-1, keepdims=True) + EPS)
    return (y * g.astype(jnp.float32)).astype(x.dtype)


def rope_tables(positions):
    inv_freq = ROPE_THETA ** (-jnp.arange(0, ROPE_DIM, 2, dtype=jnp.float32) / ROPE_DIM)
    ang = positions.astype(jnp.float32)[..., None] * inv_freq
    return jnp.cos(ang), jnp.sin(ang)


def apply_rope(x, cos, sin):
    xf = x.astype(jnp.float32)
    x1, x2 = jnp.split(xf, 2, axis=-1)
    c, s = cos[:, :, None, :], sin[:, :, None, :]
    return jnp.concatenate([x1 * c - x2 * s, x2 * c + x1 * s], axis=-1).astype(x.dtype)


def diff_attention(h, w_qkv, w_o, lam, subln, cos, sin, layer_idx):
    B, S, _ = h.shape
    H, d = DIFF_HEADS, DIFF_HEAD_DIM
    q, k, v = jnp.split(h @ w_qkv, 3, axis=-1)
    q = apply_rope(q.reshape(B, S, 2 * H, d), cos, sin)
    k = apply_rope(k.reshape(B, S, 2 * H, d), cos, sin)
    v = v.reshape(B, S, H, 2 * d)
    lam_init = 0.8 - 0.6 * math.exp(-0.3 * layer_idx)
    lf = lam.astype(jnp.float32)
    lam_full = jnp.exp(jnp.sum(lf[0] * lf[1])) - jnp.exp(jnp.sum(lf[2] * lf[3])) + lam_init
    scale = d ** -0.5
    nb = S // DIFF_Q_BLOCK
    q_blocks = jnp.moveaxis(q.reshape(B, nb, DIFF_Q_BLOCK, 2 * H, d), 1, 0)

    def one_block(qb):
        s = jnp.einsum('bqhd,bkhd->bhqk', qb, k).astype(jnp.float32) * scale
        pr = jax.nn.softmax(s, axis=-1).reshape(B, H, 2, DIFF_Q_BLOCK, S)
        a = (pr[:, :, 0] - lam_full * pr[:, :, 1]).astype(v.dtype)
        return jnp.einsum('bhqk,bkhe->bqhe', a, v)

    o = lax.map(one_block, q_blocks)
    o = jnp.moveaxis(o, 0, 1).reshape(B, S, H, 2 * d)
    o = rms_norm(o, subln) * (1.0 - lam_init)
    return o.reshape(B, S, H * 2 * d) @ w_o


def windowed_gqa(h, w_qkv, w_o, sinks, cos, sin):
    B, S, _ = h.shape
    Hq, Hkv, G, d, L = SWA_Q_HEADS, SWA_KV_HEADS, SWA_GROUP, SWA_HEAD_DIM, SWA_BLOCK
    nb = S // L
    q, k, v = jnp.split(h @ w_qkv, [Hq * d, Hq * d + Hkv * d], axis=-1)
    q = apply_rope(q.reshape(B, S, Hq, d), cos, sin).reshape(B, nb, L, Hkv, G, d)
    k = apply_rope(k.reshape(B, S, Hkv, d), cos, sin)
    v = v.reshape(B, S, Hkv, d)

    def band(t):
        tp = jnp.pad(t, ((0, 0), (L, L), (0, 0), (0, 0))).reshape(B, nb + 2, L, Hkv, d)
        return jnp.concatenate([tp[:, :-2], tp[:, 1:-1], tp[:, 2:]], axis=2)

    kb, vb = band(k), band(v)
    s = jnp.einsum('bnqhgd,bnchd->bnhgqc', q, kb).astype(jnp.float32) * (d ** -0.5)
    blk = jnp.arange(nb)[:, None, None] * L
    qpos = blk + jnp.arange(L)[None, :, None]
    kpos = blk - L + jnp.arange(3 * L)[None, None, :]
    mask = (jnp.abs(kpos - qpos) <= WINDOW) & (kpos >= 0) & (kpos < S)
    s = jnp.where(mask[None, :, None, None], s, -jnp.inf)
    sink = sinks.astype(jnp.float32).reshape(1, 1, Hkv, G, 1, 1)
    m = jnp.maximum(jnp.max(s, axis=-1, keepdims=True), sink)
    e = jnp.exp(s - m)
    pr = e / (jnp.sum(e, axis=-1, keepdims=True) + jnp.exp(sink - m))
    o = jnp.einsum('bnhgqc,bnchd->bnqhgd', pr.astype(v.dtype), vb).reshape(B, S, Hq * d)
    return o @ w_o


def conv_ffn(h, w_up, conv_w, conv_b, w_down):
    S = h.shape[1]
    u = h @ w_up
    pad = CONV_WIDTH // 2
    up = jnp.pad(u, ((0, 0), (pad, pad), (0, 0)))
    u = sum(up[:, t:t + S] * conv_w[t] for t in range(CONV_WIDTH)) + conv_b
    gate, val = jnp.split(u, 2, axis=-1)
    return (jax.nn.silu(gate) * val) @ w_down


def setup_inputs(seed: int = 0) -> dict:
    key = jax.random.key(seed)
    ks = jax.random.split(key, 24)
    D = D_MODEL

    def nrm(k, shape, scale):
        return jax.random.normal(k, shape, jnp.float32) * scale

    return {
        "x": nrm(ks[0], (BATCH, SEQ, D), 1.0),
        "p": nrm(ks[1], (DEPTH, BATCH, SEQ, PLE_DIM), 1.0),
        "positions": jnp.broadcast_to(jnp.arange(SEQ, dtype=jnp.int32), (BATCH, SEQ)),
        "attn_norm": 1.0 + nrm(ks[2], (DEPTH, D), 0.05),
        "ffn_norm": 1.0 + nrm(ks[3], (DEPTH, D), 0.05),
        "ple_norm": 1.0 + nrm(ks[4], (DEPTH, D), 0.05),
        "final_norm": 1.0 + nrm(ks[5], (D,), 0.05),
        "diff_w_qkv": nrm(ks[6], (N_DIFF_LAYERS, D, 3 * D), D ** -0.5),
        "diff_w_o": nrm(ks[7], (N_DIFF_LAYERS, D, D), D ** -0.5),
        "diff_lambda": nrm(ks[8], (N_DIFF_LAYERS, 4, DIFF_HEAD_DIM), 0.1),
        "diff_subln": 1.0 + nrm(ks[9], (N_DIFF_LAYERS, 2 * DIFF_HEAD_DIM), 0.05),
        "swa_w_qkv": nrm(ks[10], (N_SWA_LAYERS, D, (SWA_Q_HEADS + 2 * SWA_KV_HEADS) * SWA_HEAD_DIM), D ** -0.5),
        "swa_w_o": nrm(ks[11], (N_SWA_LAYERS, SWA_Q_HEADS * SWA_HEAD_DIM, D), D ** -0.5),
        "swa_sinks": nrm(ks[12], (N_SWA_LAYERS, SWA_Q_HEADS), 0.5),
        "ffn_w_up": nrm(ks[13], (DEPTH, D, 2 * D_FF), D ** -0.5),
        "ffn_conv_w": nrm(ks[14], (DEPTH, CONV_WIDTH, 2 * D_FF), CONV_WIDTH ** -0.5),
        "ffn_conv_b": nrm(ks[15], (DEPTH, 2 * D_FF), 0.02),
        "ffn_w_down": nrm(ks[16], (DEPTH, D_FF, D), D_FF ** -0.5),
        "ple_w_proj": nrm(ks[17], (DEPTH, PLE_DIM, D), PLE_DIM ** -0.5),
        "ple_w_gate": nrm(ks[18], (DEPTH, D, D), D ** -0.5),
    }


def reference(x, p, positions, attn_norm, ffn_norm, ple_norm, final_norm,
              diff_w_qkv, diff_w_o, diff_lambda, diff_subln,
              swa_w_qkv, swa_w_o, swa_sinks,
              ffn_w_up, ffn_conv_w, ffn_conv_b, ffn_w_down,
              ple_w_proj, ple_w_gate):
    cos, sin = rope_tables(positions)
    h = x
    for i in range(DEPTH):
        j = i // N_MIXERS
        hn = rms_norm(h, attn_norm[i])
        if i % N_MIXERS == 0:
            mix = diff_attention(hn, diff_w_qkv[j], diff_w_o[j], diff_lambda[j], diff_subln[j], cos, sin, i)
        else:
            mix = windowed_gqa(hn, swa_w_qkv[j], swa_w_o[j], swa_sinks[j], cos, sin)
        h = h + mix
        h = h + conv_ffn(rms_norm(h, ffn_norm[i]), ffn_w_up[i], ffn_conv_w[i], ffn_conv_b[i], ffn_w_down[i])
        gate = jax.nn.sigmoid(rms_norm(h, ple_norm[i]) @ ple_w_gate[i])
        h = h + (p[i] @ ple_w_proj[i]) * gate
    return rms_norm(h, final_norm)
```

```cpp
#include <hip/hip_runtime.h>
#include <hip/hip_cooperative_groups.h>
#include <cstdio>
#include <cstdint>
namespace cg = cooperative_groups;
#ifndef MK_ONE_LAUNCH
#define MK_ONE_LAUNCH 1
#endif
#define TID_TBL 131136u
__device__ __forceinline__ unsigned hw_wave_slot() { return (unsigned)__builtin_amdgcn_s_getreg((5 << 11) | 4) & 63u; }
__device__ __forceinline__ int tidx() {
    const int w = *reinterpret_cast<volatile __attribute__((address_space(3))) int*>(TID_TBL + 4u * hw_wave_slot());
    unsigned ones_ = ~0u; asm volatile("" : "+s"(ones_));
    int t = w * 64 + (int)__builtin_amdgcn_mbcnt_hi(ones_, __builtin_amdgcn_mbcnt_lo(ones_, 0u));
    asm volatile("" : "+v"(t)); return t;
}
__device__ __forceinline__ int bidx() { int t = blockIdx.x; asm volatile("" : "+s"(t)); return t; }
__device__ __forceinline__ int gdim() { int t = gridDim.x; asm volatile("" : "+s"(t)); return t; }
namespace pg8 {
#define PG8_LAS __attribute__((address_space(3)))
typedef unsigned short bf16_t;
typedef short bf16x8 __attribute__((ext_vector_type(8)));
typedef float f32x4 __attribute__((ext_vector_type(4)));
typedef unsigned u32x4 __attribute__((ext_vector_type(4)));
constexpr int BM = 256, BK = 64, HALF = 128, HTB = HALF * BK * 2  , STAGE_BYTES = 8 * HTB, NXCD = 8, WGM = 8;

__host__ __device__ __forceinline__ int lds_byte(int r, int c) { const int st = (r >> 4) * 2 + (c >> 5), rr = r & 15, cc = c & 31, ob = rr * 64 + cc * 2; return st * 1024 + (ob ^ (((ob >> 9) & 1) << 5)); }
__host__ __device__ __forceinline__ void stage_rc(int b, int& R, int& C) { const int st = b / 1024, sb = b % 1024, swz = sb ^ (((sb >> 9) & 1) << 5); R = (st >> 1) * 16 + swz / 64; C = (st & 1) * 32 + (swz % 64) / 2; }
__host__ __device__ __forceinline__ int perm32(int rho) { const int n = rho >> 4, i = rho & 15; return 8 * (i >> 2) + 4 * n + (i & 3); }

struct Unit { int pm, pn; };
struct Gemm { const bf16_t* A; const bf16_t* Bt; int M, N, K; };

struct StaticOrder {
    int nM, nN, nwg, G, c, nI, rev;
    __host__ __device__ void init(int M, int N, int G_, int c_, int rev_ = 0) { nM = M / BM; nN = N / BM; nwg = nM * nN; G = G_; c = c_; rev = rev_; nI = c_ < nwg ? (nwg - c_ + G_ - 1) / G_ : 0; }
    __host__ __device__ bool next(int i, Unit& u) const {
        if (i >= nI) return false;
        const long L = (long)(rev ? nI - 1 - i : i) * G + c;
        int wgid = (int)L; { const int q = nwg / NXCD, r = nwg % NXCD, xcd = wgid % NXCD, off = wgid / NXCD; wgid = (xcd < r ? xcd * (q + 1) : r * (q + 1) + (xcd - r) * q) + off; }
        const int nig = WGM * nN, gid = wgid / nig, fm = gid * WGM, gsz = (nM - fm) < WGM ? (nM - fm) : WGM;
        u.pm = fm + ((wgid % nig) % gsz); u.pn = (wgid % nig) / gsz; return true;
    }
    __device__ __forceinline__ void a_ready(const Unit&) const {}
    __device__ __forceinline__ void done(const Unit&) const {}
};

typedef float f32x2_cv __attribute__((ext_vector_type(2))); typedef __bf16 bf16x2_cv __attribute__((ext_vector_type(2)));
__device__ __forceinline__ unsigned cvt_pk_bf16(float lo, float hi) { const f32x2_cv v = {lo, hi}; const bf16x2_cv b = __builtin_convertvector(v, bf16x2_cv); return __builtin_bit_cast(unsigned, b); }
typedef float f32x2 __attribute__((ext_vector_type(2)));
template <class Epi, class Sched, bool ALIGN_EPI = false, bool SP2 = false>
__device__ __forceinline__ void gemm_phase(PG8_LAS unsigned char* lds, const Gemm g, const Sched& S, const Epi& E) {
    int tid_ = tidx();
    const int tid = tid_, wid = __builtin_amdgcn_readfirstlane(tid >> 6), lane = tid & 63, wr = wid >> 2, wc = wid & 3, fr = lane & 15, fq = lane >> 4;
    const int K = g.K, nt = K / BK;
    unsigned voffA[2], voffB[2];
#pragma unroll
    for (int i = 0; i < 2; ++i) { int R, C; stage_rc(tid * 16 + i * 8192, R, C); const int Rb = Epi::PERM ? ((R & ~31) + perm32(R & 31)) : R;
        voffA[i] = (unsigned)(R * K + C) * 2u; voffB[i] = (unsigned)(Rb * K + C) * 2u; }
    const size_t kstep = (size_t)(BK * 2);
    const size_t hstep = (size_t)HALF * K * 2;
    const size_t tstep = 2 * hstep;
    const unsigned ldsw = (unsigned)wid * 1024u;
    const int aoff = lds_byte(wr * 64 + fr, fq * 8), boff = lds_byte(wc * 32 + fr, fq * 8);
#define PG8_SA(b, h) (((b) * 2 + (h)) * HTB)
#define PG8_SB(b, h) ((4 + (b) * 2 + (h)) * HTB)
#define PG8_STAGE(bufoff, gbase, voff) do { _Pragma("unroll") for (int _i = 0; _i < 2; ++_i) \
        __builtin_amdgcn_global_load_lds((const unsigned*)((const char*)(gbase) + (voff)[_i]), (PG8_LAS unsigned*)(lds + (bufoff) + ldsw + _i * 8192), 16, 0, 0); } while (0)
#define PG8_LDA(dst, b, h) do { _Pragma("unroll") for (int m = 0; m < 4; ++m) _Pragma("unroll") for (int k = 0; k < 2; ++k) dst[m][k] = *(const PG8_LAS bf16x8*)(lds + PG8_SA(b, h) + aoff + m * 2048 + k * 1024); } while (0)
#define PG8_LDB(dst, b, h) do { _Pragma("unroll") for (int n = 0; n < 2; ++n) _Pragma("unroll") for (int k = 0; k < 2; ++k) dst[n][k] = *(const PG8_LAS bf16x8*)(lds + PG8_SB(b, h) + boff + n * 2048 + k * 1024); } while (0)
#define PG8_MMA(ai, bj, At, Bt) do { __builtin_amdgcn_s_setprio(1); _Pragma("unroll") for (int m = 0; m < 4; ++m) _Pragma("unroll") for (int n = 0; n < 2; ++n) _Pragma("unroll") for (int k = 0; k < 2; ++k) \
        acc[ai][bj][m][n] = __builtin_amdgcn_mfma_f32_16x16x32_bf16(Bt[n][k], At[m][k], acc[ai][bj][m][n], 0, 0, 0); __builtin_amdgcn_s_setprio(0); } while (0)
#define PG8_WAIT_V(n) asm volatile("s_waitcnt vmcnt(" #n ")" ::: "memory")
#define PG8_WAIT_L(n) asm volatile("s_waitcnt lgkmcnt(" #n ")" ::: "memory")
#define PG8_BAR __builtin_amdgcn_s_barrier()
#define PG8_SCHED __builtin_amdgcn_sched_barrier(0)
    Unit cur, nxt; int ui = 0;
    if (!S.next(0, cur)) return;
    f32x4 acc[2][2][4][2];
#pragma unroll
    for (int a = 0; a < 2; ++a)
#pragma unroll
        for (int b = 0; b < 2; ++b)
#pragma unroll
            for (int m = 0; m < 4; ++m)
#pragma unroll
                for (int n = 0; n < 2; ++n) acc[a][b][m][n] = (f32x4){0.f, 0.f, 0.f, 0.f};
    bf16x8 At[4][2], B0[2][2], B1[2][2];
    const char* cA = (const char*)g.A + (size_t)cur.pm * tstep; const char* cB = (const char*)g.Bt + (size_t)cur.pn * tstep;
    S.a_ready(cur);
    if constexpr (SP2) {
        PG8_STAGE(PG8_SB(0, 0), cB, voffB); PG8_STAGE(PG8_SB(0, 1), cB + hstep, voffB); PG8_STAGE(PG8_SA(0, 0), cA, voffA); PG8_STAGE(PG8_SA(0, 1), cA + hstep, voffA);
        if (wr == 1) PG8_BAR;
        PG8_WAIT_V(2); PG8_BAR;
        PG8_STAGE(PG8_SB(1, 0), cB + kstep, voffB); PG8_STAGE(PG8_SA(1, 0), cA + kstep, voffA); PG8_STAGE(PG8_SB(1, 1), cB + hstep + kstep, voffB);
        PG8_WAIT_V(6); PG8_BAR;
    } else {
        PG8_STAGE(PG8_SB(0, 0), cB, voffB); PG8_STAGE(PG8_SA(0, 0), cA, voffA); PG8_STAGE(PG8_SB(0, 1), cB + hstep, voffB); PG8_STAGE(PG8_SA(0, 1), cA + hstep, voffA);
        if (wr == 1) PG8_BAR;
        PG8_WAIT_V(4); PG8_BAR;
        PG8_STAGE(PG8_SB(1, 0), cB + kstep, voffB); PG8_STAGE(PG8_SA(1, 0), cA + kstep, voffA); PG8_STAGE(PG8_SB(1, 1), cB + hstep + kstep, voffB);
        PG8_WAIT_V(6); PG8_BAR;
    }
    for (;;) {
        const bool has_next = S.next(ui + 1, nxt);
        const char* nA = has_next ? (const char*)g.A + (size_t)nxt.pm * tstep : cA; const char* nB = has_next ? (const char*)g.Bt + (size_t)nxt.pn * tstep : cB;
        for (int t = 0; t < nt; t += 2) {
            const bool last = (t == nt - 2);
            const char* a1 = cA + (size_t)(t + 1) * kstep;
            const char* a2 = last ? nA : cA + (size_t)(t + 2) * kstep; const char* b2 = last ? nB : cB + (size_t)(t + 2) * kstep;
            const char* a3 = a2 + kstep; const char* b3 = b2 + kstep;
            if (last && has_next) S.a_ready(nxt);
            if constexpr (SP2) {
            PG8_LDB(B0, 0, 0); PG8_LDB(B1, 0, 1); PG8_SCHED; PG8_LDA(At, 0, 0); PG8_STAGE(PG8_SA(1, 1), a1 + hstep, voffA);
            PG8_WAIT_V(8); PG8_WAIT_L(0); PG8_BAR; PG8_MMA(0, 0, At, B0); PG8_MMA(0, 1, At, B1); PG8_BAR; PG8_SCHED;
            PG8_LDA(At, 0, 1); PG8_STAGE(PG8_SB(0, 0), b2, voffB); PG8_STAGE(PG8_SB(0, 1), b2 + hstep, voffB); PG8_STAGE(PG8_SA(0, 0), a2, voffA);
            PG8_WAIT_V(8); PG8_WAIT_L(0); PG8_BAR; PG8_MMA(1, 0, At, B0); PG8_MMA(1, 1, At, B1); PG8_BAR; PG8_SCHED;
            PG8_LDB(B0, 1, 0); PG8_LDB(B1, 1, 1); PG8_SCHED; PG8_LDA(At, 1, 0); PG8_STAGE(PG8_SA(0, 1), a2 + hstep, voffA);
            PG8_WAIT_V(8); PG8_WAIT_L(0); PG8_BAR; PG8_MMA(0, 0, At, B0); PG8_MMA(0, 1, At, B1); PG8_BAR; PG8_SCHED;
            PG8_LDA(At, 1, 1); PG8_STAGE(PG8_SB(1, 0), b3, voffB); PG8_STAGE(PG8_SB(1, 1), b3 + hstep, voffB); PG8_STAGE(PG8_SA(1, 0), a3, voffA);
            PG8_WAIT_V(8); PG8_WAIT_L(0); PG8_BAR; PG8_MMA(1, 0, At, B0); PG8_MMA(1, 1, At, B1); PG8_BAR; PG8_SCHED;
            } else {
            PG8_LDB(B0, 0, 0); PG8_SCHED; PG8_LDA(At, 0, 0); PG8_STAGE(PG8_SA(1, 1), a1 + hstep, voffA);
            PG8_WAIT_L(8); PG8_BAR; PG8_WAIT_L(0); PG8_MMA(0, 0, At, B0); PG8_BAR; PG8_SCHED;
            PG8_LDB(B1, 0, 1); PG8_STAGE(PG8_SB(0, 0), b2, voffB);
            PG8_BAR; PG8_WAIT_L(0); PG8_MMA(0, 1, At, B1); PG8_BAR;
            PG8_LDA(At, 0, 1); PG8_STAGE(PG8_SA(0, 0), a2, voffA);
            PG8_BAR; PG8_WAIT_L(0); PG8_MMA(1, 0, At, B0); PG8_BAR; PG8_SCHED;
            PG8_STAGE(PG8_SB(0, 1), b2 + hstep, voffB);
            PG8_WAIT_V(6); PG8_BAR; PG8_MMA(1, 1, At, B1); PG8_BAR;
            PG8_LDB(B0, 1, 0); PG8_SCHED; PG8_LDA(At, 1, 0); PG8_STAGE(PG8_SA(0, 1), a2 + hstep, voffA);
            PG8_WAIT_L(8); PG8_BAR; PG8_WAIT_L(0); PG8_MMA(0, 0, At, B0); PG8_BAR; PG8_SCHED;
            PG8_LDB(B1, 1, 1); PG8_STAGE(PG8_SB(1, 0), b3, voffB);
            PG8_BAR; PG8_WAIT_L(0); PG8_MMA(0, 1, At, B1); PG8_BAR;
            PG8_LDA(At, 1, 1); PG8_STAGE(PG8_SA(1, 0), a3, voffA);
            PG8_BAR; PG8_WAIT_L(0); PG8_MMA(1, 0, At, B0); PG8_BAR; PG8_SCHED;
            PG8_STAGE(PG8_SB(1, 1), b3 + hstep, voffB);
            PG8_WAIT_V(6); PG8_BAR; PG8_MMA(1, 1, At, B1); PG8_BAR;
            }
        }
        if constexpr (ALIGN_EPI) { if (wr == 0) PG8_BAR; }
        if constexpr (!Epi::AFTER_DRAIN) { E(acc, cur, wr, wc, fr, fq); S.done(cur); }
        if (!has_next) break;
#pragma unroll
        for (int a = 0; a < 2; ++a)
#pragma unroll
            for (int b = 0; b < 2; ++b)
#pragma unroll
                for (int m = 0; m < 4; ++m)
#pragma unroll
                    for (int n = 0; n < 2; ++n) acc[a][b][m][n] = (f32x4){0.f, 0.f, 0.f, 0.f};
        cur = nxt; cA = nA; cB = nB; ++ui;
        if constexpr (ALIGN_EPI) { if (wr == 1) PG8_BAR; }
    }
    PG8_WAIT_V(0);
    if constexpr (!ALIGN_EPI) { if (wr == 0) PG8_BAR; }
    PG8_BAR;
    if constexpr (Epi::AFTER_DRAIN) { E.fused(acc, cur, wr, wc, fr, fq, lds, wid, lane); S.done(cur); }
#undef PG8_SA
#undef PG8_SB
#undef PG8_STAGE
#undef PG8_LDA
#undef PG8_LDB
#undef PG8_MMA
#undef PG8_WAIT_V
#undef PG8_WAIT_L
#undef PG8_BAR
#undef PG8_SCHED
}
}
using pg8::bf16_t; using pg8::f32x4; using pg8::bf16x8; using pg8::Unit;
#define LAS __attribute__((address_space(3)))
typedef float f32x16 __attribute__((ext_vector_type(16)));
typedef short s16x4 __attribute__((ext_vector_type(4)));
typedef unsigned u32x4 __attribute__((ext_vector_type(4)));
typedef unsigned u32x2 __attribute__((ext_vector_type(2)));

constexpr int BATCH = 8, SEQ = 4096, DM = 1024, T = BATCH * SEQ, DEPTH = 4, DFF = 2816, PLE = 256;
constexpr float EPS = 1e-6f, LOG2E = 1.4426950408889634f;
constexpr size_t MiB = 1u << 20;
constexpr size_t WS_W = 0, W_LAYER = 27 * MiB, W_QKV = 0, W_O = 6 * MiB, W_UP = 8 * MiB, W_DOWN = 19 * MiB, W_GATE = 24 * MiB + MiB / 2, W_PROJ = 26 * MiB + MiB / 2;
constexpr size_t WS_COS = 108 * MiB, WS_SIN = 112 * MiB, WS_XN = 116 * MiB, WS_Q = 180 * MiB, WS_K = 244 * MiB, WS_V = 308 * MiB, WS_ACT = WS_Q;
constexpr size_t WS_O = 372 * MiB, WS_G = WS_O, WS_HALO = WS_O  , WS_PB = 356 * MiB  ;
constexpr size_t WS_LO = 436 * MiB, WS_SS = 500 * MiB, WS_BAR = 502 * MiB, WS_END = 503 * MiB;
constexpr int LDS_BYTES = 131072 + 4096;
constexpr int NPHASE = 2 + 7 * DEPTH;

__device__ __forceinline__ float shfl_xor_l(float v, int o, int lane) { return __builtin_bit_cast(float, __builtin_amdgcn_ds_bpermute((lane ^ o) << 2, __builtin_bit_cast(int, v))); }
__device__ __forceinline__ float wave_sum(float v, int lane) {
#pragma unroll
    for (int o = 32; o >= 1; o >>= 1) v += shfl_xor_l(v, o, lane);
    return v;
}
__device__ __forceinline__ u32x2 pack4(f32x4 v) { u32x2 w; w.x = pg8::cvt_pk_bf16(v[0], v[1]); w.y = pg8::cvt_pk_bf16(v[2], v[3]); return w; }
__device__ __forceinline__ float bf2f(unsigned short b) { return __builtin_bit_cast(float, (unsigned)b << 16); }
__device__ __forceinline__ f32x4 unpack4(u32x2 w) { f32x4 r; r[0] = __builtin_bit_cast(float, w.x << 16); r[1] = __builtin_bit_cast(float, w.x & 0xffff0000u); r[2] = __builtin_bit_cast(float, w.y << 16); r[3] = __builtin_bit_cast(float, w.y & 0xffff0000u); return r; }
__device__ __forceinline__ void unpack8(u32x4 w, f32x4& a, f32x4& b_) { u32x2 l; l.x = w.x; l.y = w.y; u32x2 h_; h_.x = w.z; h_.y = w.w; a = unpack4(l); b_ = unpack4(h_); }
__device__ __forceinline__ u32x4 pack8(f32x4 a, f32x4 b_) { const u32x2 l = pack4(a), h_ = pack4(b_); u32x4 w; w.x = l.x; w.y = l.y; w.z = h_.x; w.w = h_.y; return w; }
__device__ __forceinline__ float sigmoidf_(float x) { return __builtin_amdgcn_rcpf(1.f + __builtin_amdgcn_exp2f(-x * LOG2E)); }
template <int CTRL> __device__ __forceinline__ float dppf(float v) { return __builtin_bit_cast(float, __builtin_amdgcn_update_dpp(0, __builtin_bit_cast(int, v), CTRL, 0xf, 0xf, true)); }
__device__ __forceinline__ f32x4 ror1(f32x4 v) { f32x4 r; r[0] = dppf<0x121>(v[0]); r[1] = dppf<0x121>(v[1]); r[2] = dppf<0x121>(v[2]); r[3] = dppf<0x121>(v[3]); return r; }
__device__ __forceinline__ f32x4 ror15(f32x4 v) { f32x4 r; r[0] = dppf<0x12F>(v[0]); r[1] = dppf<0x12F>(v[1]); r[2] = dppf<0x12F>(v[2]); r[3] = dppf<0x12F>(v[3]); return r; }

__device__ __forceinline__ float row_rstd(const float* SS, int row, int fr, int fq) {
    const f32x4 a = *(const f32x4*)(SS + (size_t)row * 16 + 4 * fq); float s = (a[0] + a[1]) + (a[2] + a[3]); const int ln_ = fr + 16 * fq;
    s += shfl_xor_l(s, 16, ln_); s += shfl_xor_l(s, 32, ln_);
    return rsqrtf(s * (1.f / DM) + EPS);
}
struct EpiQKV {
    static constexpr bool PERM = true, AFTER_DRAIN = false;
    bf16_t *Q, *K, *V; int nq, nk, kpitch, vpitch; const float* cosT; const float* sinT; float qscale; const float* SS;
    __device__ __forceinline__ void operator()(const f32x4 (&acc)[2][2][4][2], const Unit& u, int wr, int wc, int fr, int fq) const {
        const int pn = u.pn, row0 = u.pm * 256 + wr * 64 + fr;
        if (pn >= nq + nk) {
            const int col0 = (pn - nq - nk) * 256 + wc * 32 + 8 * fq;
#pragma unroll
            for (int ai = 0; ai < 2; ++ai)
#pragma unroll
                for (int m = 0; m < 4; ++m) { bf16_t* rp = V + (size_t)(row0 + ai * 128 + m * 16) * vpitch + col0; const float rs = row_rstd(SS, row0 + ai * 128 + m * 16, fr, fq);
#pragma unroll
                    for (int bj = 0; bj < 2; ++bj) { const u32x2 w0 = pack4(acc[ai][bj][m][0] * rs), w1 = pack4(acc[ai][bj][m][1] * rs); u32x4 w; w.x = w0.x; w.y = w0.y; w.z = w1.x; w.w = w1.y; *(u32x4*)(rp + bj * 128) = w; } }
        } else {
            const bool isq = pn < nq; bf16_t* base = isq ? Q : K; const int pitch = isq ? DM : kpitch, ct = (isq ? pn : pn - nq) * 256;
            const float sc = isq ? qscale : 1.f; const int ri = 8 * fq, hc = ct + 64 * wc + ri;
#pragma unroll
            for (int ai = 0; ai < 2; ++ai)
#pragma unroll
                for (int m = 0; m < 4; ++m) { const int row = row0 + ai * 128 + m * 16; const float scr_ = sc * row_rstd(SS, row, fr, fq);
                    const float* cp = cosT + (size_t)row * 32 + ri; const float* sp = sinT + (size_t)row * 32 + ri;
                    const f32x4 c0 = *(const f32x4*)cp * scr_, c1 = *(const f32x4*)(cp + 4) * scr_, s0 = *(const f32x4*)sp * scr_, s1 = *(const f32x4*)(sp + 4) * scr_;
                    const f32x4 xa0 = acc[ai][0][m][0], xa1 = acc[ai][0][m][1], xb0 = acc[ai][1][m][0], xb1 = acc[ai][1][m][1];
                    const u32x2 p0 = pack4(xa0 * c0 - xb0 * s0), p1 = pack4(xa1 * c1 - xb1 * s1), q0 = pack4(xb0 * c0 + xa0 * s0), q1 = pack4(xb1 * c1 + xa1 * s1);
                    bf16_t* dst = base + (size_t)row * pitch + hc; u32x4 w;
                    w.x = p0.x; w.y = p0.y; w.z = p1.x; w.w = p1.y; *(u32x4*)dst = w;
                    w.x = q0.x; w.y = q0.y; w.z = q1.x; w.w = q1.y; *(u32x4*)(dst + 32) = w; }
        }
    }
};
template <bool XIN> struct EpiRes {
    static constexpr bool PERM = true, AFTER_DRAIN = false;
    const float* xin; bf16_t* HB; bf16_t* LO; float* SS;
    __device__ __forceinline__ void operator()(const f32x4 (&acc)[2][2][4][2], const Unit& u, int wr, int wc, int fr, int fq) const {
        const int col0 = u.pn * 256 + wc * 32 + 8 * fq, row0 = u.pm * 256 + wr * 64 + fr;
#pragma unroll
        for (int ai = 0; ai < 2; ++ai)
#pragma unroll
            for (int m = 0; m < 4; ++m) { const int row = row0 + ai * 128 + m * 16; const size_t off = (size_t)row * DM + col0; float ss = 0.f;
#pragma unroll
                for (int bj = 0; bj < 2; ++bj) { const size_t o = off + bj * 128; f32x4 v0, v1;
                    if (XIN) { v0 = *(const f32x4*)(xin + o); v1 = *(const f32x4*)(xin + o + 4); }
                    else { f32x4 a0, a1, l0, l1; unpack8(*(const u32x4*)(HB + o), a0, a1); unpack8(*(const u32x4*)(LO + o), l0, l1); v0 = a0 + l0; v1 = a1 + l1; }
                    v0 += acc[ai][bj][m][0]; v1 += acc[ai][bj][m][1];
                    const u32x4 w = pack8(v0, v1); f32x4 r0, r1; unpack8(w, r0, r1);
                    *(u32x4*)(HB + o) = w; *(u32x4*)(LO + o) = pack8(v0 - r0, v1 - r1);
                    ss += ((v0[0] * v0[0] + v0[1] * v0[1]) + (v0[2] * v0[2] + v0[3] * v0[3])) + ((v1[0] * v1[0] + v1[1] * v1[1]) + (v1[2] * v1[2] + v1[3] * v1[3])); }
                { const int ln_ = fr + 16 * fq; ss += shfl_xor_l(ss, 16, ln_); ss += shfl_xor_l(ss, 32, ln_); }
                if (fq == 0) SS[(size_t)row * 16 + u.pn * 4 + wc] = ss;
                }
    }
};
struct EpiGate {
    static constexpr bool PERM = true, AFTER_DRAIN = false;
    bf16_t* G; const float* SS;
    __device__ __forceinline__ void operator()(const f32x4 (&acc)[2][2][4][2], const Unit& u, int wr, int wc, int fr, int fq) const {
        const int col0 = u.pn * 256 + wc * 32 + 8 * fq, row0 = u.pm * 256 + wr * 64 + fr;
#pragma unroll
        for (int ai = 0; ai < 2; ++ai)
#pragma unroll
            for (int m = 0; m < 4; ++m) { const size_t off = (size_t)(row0 + ai * 128 + m * 16) * DM + col0; const float rs = row_rstd(SS, row0 + ai * 128 + m * 16, fr, fq);
#pragma unroll
                for (int bj = 0; bj < 2; ++bj) { const f32x4 a0 = acc[ai][bj][m][0] * rs, a1 = acc[ai][bj][m][1] * rs; f32x4 s0, s1;
                    s0[0] = sigmoidf_(a0[0]); s0[1] = sigmoidf_(a0[1]); s0[2] = sigmoidf_(a0[2]); s0[3] = sigmoidf_(a0[3]); s1[0] = sigmoidf_(a1[0]); s1[1] = sigmoidf_(a1[1]); s1[2] = sigmoidf_(a1[2]); s1[3] = sigmoidf_(a1[3]);
                    const u32x2 w0 = pack4(s0), w1 = pack4(s1); u32x4 w; w.x = w0.x; w.y = w0.y; w.z = w1.x; w.w = w1.y; *(u32x4*)(G + off + bj * 128) = w; } }
    }
};
struct EpiProj {
    static constexpr bool PERM = true, AFTER_DRAIN = false;
    const bf16_t* G; bf16_t* HB; bf16_t* LO; float* SS;
    __device__ __forceinline__ void operator()(const f32x4 (&acc)[2][2][4][2], const Unit& u, int wr, int wc, int fr, int fq) const {
        const int col0 = u.pn * 256 + wc * 32 + 8 * fq, row0 = u.pm * 256 + wr * 64 + fr;
#pragma unroll
        for (int ai = 0; ai < 2; ++ai)
#pragma unroll
            for (int m = 0; m < 4; ++m) { const int row = row0 + ai * 128 + m * 16; const size_t off = (size_t)row * DM + col0; float ss = 0.f;
#pragma unroll
                for (int bj = 0; bj < 2; ++bj) { const size_t o = off + bj * 128; f32x4 g0, g1, a0, a1, l0, l1;
                    unpack8(*(const u32x4*)(G + o), g0, g1); unpack8(*(const u32x4*)(HB + o), a0, a1); unpack8(*(const u32x4*)(LO + o), l0, l1);
                    const f32x4 v0 = (a0 + l0) + acc[ai][bj][m][0] * g0, v1 = (a1 + l1) + acc[ai][bj][m][1] * g1;
                    const u32x4 w = pack8(v0, v1); f32x4 r0, r1; unpack8(w, r0, r1);
                    *(u32x4*)(HB + o) = w; *(u32x4*)(LO + o) = pack8(v0 - r0, v1 - r1);
                    ss += ((v0[0] * v0[0] + v0[1] * v0[1]) + (v0[2] * v0[2] + v0[3] * v0[3])) + ((v1[0] * v1[0] + v1[1] * v1[1]) + (v1[2] * v1[2] + v1[3] * v1[3])); }
                { const int ln_ = fr + 16 * fq; ss += shfl_xor_l(ss, 16, ln_); ss += shfl_xor_l(ss, 32, ln_); }
                if (fq == 0) SS[(size_t)row * 16 + u.pn * 4 + wc] = ss;
                }
    }
};
struct EpiUp {
    static constexpr bool PERM = false, AFTER_DRAIN = false;
    bf16_t* ACT; bf16_t* HALO; const float* cw; const float* cb; const float* SS;
    __device__ __forceinline__ void operator()(const f32x4 (&acc)[2][2][4][2], const Unit& u, int wr, int wc, int fr, int fq) const {
        float rs[2][4];
#pragma unroll
        for (int ai = 0; ai < 2; ++ai) {
#pragma unroll
            for (int m = 0; m < 4; ++m) rs[ai][m] = row_rstd(SS, u.pm * 256 + ai * 128 + wr * 64 + m * 16 + fr, fr, fq); }
#pragma unroll
        for (int n = 0; n < 2; ++n) {
            const int c0 = u.pn * 128 + wc * 32 + n * 16 + 4 * fq;
            const f32x4 g0 = *(const f32x4*)(cw + c0), g1 = *(const f32x4*)(cw + 2 * DFF + c0), g2 = *(const f32x4*)(cw + 4 * DFF + c0), gb = *(const f32x4*)(cb + c0);
            const f32x4 v0 = *(const f32x4*)(cw + DFF + c0), v1 = *(const f32x4*)(cw + 3 * DFF + c0), v2 = *(const f32x4*)(cw + 5 * DFF + c0), vb = *(const f32x4*)(cb + DFF + c0);
#pragma unroll
            for (int ai = 0; ai < 2; ++ai) {
                const int grp = 4 * u.pm + 2 * ai + wr;
                f32x4 Gs[4], Vs[4];
#pragma unroll
                for (int m = 0; m < 4; ++m) { Gs[m] = acc[ai][0][m][n] * rs[ai][m]; Vs[m] = acc[ai][1][m][n] * rs[ai][m]; }
#pragma unroll
                for (int m = 0; m < 4; ++m) {
                    const f32x4 g = Gs[m], v = Vs[m];
                    f32x4 gp = ror1(g), gn = ror15(g), vp = ror1(v), vn = ror15(v);
                    if (m > 0) { const f32x4 tg = ror1(Gs[m > 0 ? m - 1 : 0]), tv = ror1(Vs[m > 0 ? m - 1 : 0]); if (fr == 0) { gp = tg; vp = tv; } }
                    if (m < 3) { const f32x4 tg = ror15(Gs[m < 3 ? m + 1 : 3]), tv = ror15(Vs[m < 3 ? m + 1 : 3]); if (fr == 15) { gn = tg; vn = tv; } }
                    const f32x4 gg = g0 * gp + g1 * g + g2 * gn + gb, vv = v0 * vp + v1 * v + v2 * vn + vb;
                    f32x4 a; a[0] = gg[0] * sigmoidf_(gg[0]) * vv[0]; a[1] = gg[1] * sigmoidf_(gg[1]) * vv[1]; a[2] = gg[2] * sigmoidf_(gg[2]) * vv[2]; a[3] = gg[3] * sigmoidf_(gg[3]) * vv[3];
                    const int row = u.pm * 256 + ai * 128 + wr * 64 + m * 16 + fr;
                    const bool edge = (m == 0 && fr == 0) || (m == 3 && fr == 15);
                    if (!edge) *(u32x2*)(ACT + (size_t)row * DFF + c0) = pack4(a);
                    if (m == 0 && fr < 2) { bf16_t* hp = HALO + (size_t)(grp * 4 + fr) * (2 * DFF) + c0; *(u32x2*)hp = pack4(g); *(u32x2*)(hp + DFF) = pack4(v); }
                    if (m == 3 && fr >= 14) { bf16_t* hp = HALO + (size_t)(grp * 4 + fr - 12) * (2 * DFF) + c0; *(u32x2*)hp = pack4(g); *(u32x2*)(hp + DFF) = pack4(v); }
                    __builtin_amdgcn_sched_barrier(0);
                }
            }
        }
    }
};
__device__ __forceinline__ void ffn_fixup_panel(const bf16_t* HALO, bf16_t* ACT, const float* cw, const float* cb, int pm) {
    constexpr int NQ = DFF / 4;
    const bool no_first = (pm & 15) == 0, no_last = (pm & 15) == 15;
    for (int cq = tidx(); cq < NQ; cq += 512) {
        const int c0 = cq * 4; const bf16_t* hb = HALO + (size_t)(16 * pm - 1) * (2 * DFF) + c0;
        u32x2 Hg[18], Hv[18];
#pragma unroll
        for (int k = 0; k < 18; ++k) { const bool ok = !(k == 0 && no_first) && !(k == 17 && no_last); const u32x2 z = {0u, 0u};
            Hg[k] = ok ? *(const u32x2*)(hb + (size_t)k * (2 * DFF)) : z; Hv[k] = ok ? *(const u32x2*)(hb + (size_t)k * (2 * DFF) + DFF) : z; }
        const f32x4 g0 = *(const f32x4*)(cw + c0), g1 = *(const f32x4*)(cw + 2 * DFF + c0), g2 = *(const f32x4*)(cw + 4 * DFF + c0), gb = *(const f32x4*)(cb + c0);
        const f32x4 v0 = *(const f32x4*)(cw + DFF + c0), v1 = *(const f32x4*)(cw + 3 * DFF + c0), v2 = *(const f32x4*)(cw + 5 * DFF + c0), vb = *(const f32x4*)(cb + DFF + c0);
#pragma unroll
        for (int r = 0; r < 8; ++r) { const int g = r >> 1, last = r & 1, hb_ = 4 * g + 3 * last, t = (4 * pm + g) * 64 + 63 * last;
            const f32x4 gg = g0 * unpack4(Hg[hb_]) + g1 * unpack4(Hg[hb_ + 1]) + g2 * unpack4(Hg[hb_ + 2]) + gb, vv = v0 * unpack4(Hv[hb_]) + v1 * unpack4(Hv[hb_ + 1]) + v2 * unpack4(Hv[hb_ + 2]) + vb;
            f32x4 a; a[0] = gg[0] * sigmoidf_(gg[0]) * vv[0]; a[1] = gg[1] * sigmoidf_(gg[1]) * vv[1]; a[2] = gg[2] * sigmoidf_(gg[2]) * vv[2]; a[3] = gg[3] * sigmoidf_(gg[3]) * vv[3];
            *(u32x2*)(ACT + (size_t)t * DFF + c0) = pack4(a); }
    }
}
__device__ __forceinline__ int crow(int r, int hi) { return (r & 3) + 8 * (r >> 2) + 4 * hi; }
__device__ __forceinline__ int koff(int row, int ch) { return row * 128 + 16 * (ch ^ ((row >> 1) & 7)); }
template <int VD> __device__ __forceinline__ int voff(int row, int ch) {
    if (VD == 128) return row * 256 + 16 * (ch ^ (((row & 3) << 2) | ((row >> 2) & 3)));
    return row * 128 + 16 * (ch ^ (((row & 3) << 1) | ((row >> 2) & 1)));
}
__device__ __forceinline__ float xhalf_max(float m) { auto rr = __builtin_amdgcn_permlane32_swap(__float_as_uint(m), __float_as_uint(m), false, false); return fmaxf(__uint_as_float(rr[0]), __uint_as_float(rr[1])); }
__device__ __forceinline__ float xhalf_sum(float m) { auto rr = __builtin_amdgcn_permlane32_swap(__float_as_uint(m), __float_as_uint(m), false, false); return __uint_as_float(rr[0]) + __uint_as_float(rr[1]); }
__device__ __forceinline__ float max3f_(float a, float b, float c) { float r; asm("v_max3_f32 %0, %1, %2, %3" : "=v"(r) : "v"(a), "v"(b), "v"(c)); return r; }
__device__ __forceinline__ u32x4 pair_swap(u32x2 a, u32x2 b) {
    auto s0 = __builtin_amdgcn_permlane32_swap(a.x, b.x, false, false); auto s1 = __builtin_amdgcn_permlane32_swap(a.y, b.y, false, false);
    u32x4 w; w.x = s0[0]; w.y = s1[0]; w.z = s0[1]; w.w = s1[1]; return w;
}
typedef short v4i16_t __attribute__((ext_vector_type(4)));
__device__ __forceinline__ s16x4 vtr(const LAS unsigned char* p) { return __builtin_bit_cast(s16x4, __builtin_amdgcn_ds_read_tr16_b64_v4i16((LAS v4i16_t*)p)); }

template <bool DIFF>
__device__ __forceinline__ void attn_phase(LAS unsigned char* lds, const bf16_t* Q, const bf16_t* K, const bf16_t* V, bf16_t* O, const float* aux, const float* subln, float lam_init) {
    constexpr int VD = DIFF ? 128 : 64, NKT = DIFF ? 2 : 1, PITCH = DIFF ? 1024 : 256;
    constexpr int BUFB = NKT * 8192 + 64 * VD * 2, NDB = VD / 32, QROWS = DIFF ? 128 : 64, NCH = DIFF ? 4 : 2, NH = DIFF ? 8 : 4;
    int tid_ = tidx();
    const int tid = tid_, lane = tid & 63, wid = __builtin_amdgcn_readfirstlane(tid >> 6), r32 = lane & 31, hi = lane >> 5;
    const int rg = DIFF ? (wid >> 1) : (wid & 1), comp = DIFF ? (wid & 1) : 0, gsub = DIFF ? 0 : (wid >> 1);
    float lam_full = 0.f;
    if (DIFF) { float a = aux[lane] * aux[64 + lane], b = aux[128 + lane] * aux[192 + lane]; a = wave_sum(a, lane); b = wave_sum(b, lane); lam_full = __builtin_bit_cast(float, __builtin_amdgcn_readfirstlane(__builtin_bit_cast(int, expf(a) - expf(b) + lam_init))); }
    const int krow = tid >> 3, kch = tid & 7, vrow = DIFF ? (tid >> 4) : (tid >> 3), vch = DIFF ? (tid & 15) : (tid & 7);
    const int sdk = koff(krow, kch), sdv = NKT * 8192 + voff<VD>(vrow, vch);
    const int q_ = (lane & 15) >> 2, p_ = lane & 3, g1 = (lane >> 4) & 1;
    int vaddr[NDB];
#pragma unroll
    for (int d = 0; d < NDB; ++d) vaddr[d] = NKT * 8192 + voff<VD>(4 * hi + q_, 4 * d + 2 * g1 + (p_ >> 1)) + 8 * (p_ & 1);
    const int G = gdim(), bx = bidx();
    for (int it = 0;; ++it) {
        int pair, qb;
        if (G == 256) { if (it >= 8) break; if (DIFF) { pair = (bx & 7) + 8 * it; qb = bx >> 3; } else { pair = (bx & 7) + 8 * (it >> 1); qb = (bx >> 3) + 32 * (it & 1); } }
        else { const int u = it * G + bx; if (u >= 2048) break; if (DIFF) { pair = u >> 5; qb = u & 31; } else { pair = u >> 6; qb = u & 63; } }
        const int b = pair / NH, h = pair % NH;
        const size_t rowbase = (size_t)b * SEQ; const int q0 = qb * QROWS, qw = q0 + 32 * rg;
        const int qcol = DIFF ? (2 * h + comp) * 64 : (h * 4 + gsub) * 64;
        const int t0 = DIFF ? 0 : (qb - 2 < 0 ? 0 : qb - 2), t1 = DIFF ? 64 : (qb + 3 > 64 ? 64 : qb + 3);
        int tu_ = tid; asm volatile("" : "+v"(tu_));
        const unsigned kel = (unsigned)((tu_ >> 3) * PITCH + (tu_ & 7) * 8), vel = DIFF ? (unsigned)((tu_ >> 4) * PITCH + (tu_ & 15) * 8) : kel;
        const bf16_t* gk = (K + rowbase * PITCH + (DIFF ? (2 * h) * 64 : h * 64)) + kel;
        const bf16_t* gv = (V + rowbase * PITCH + h * VD) + vel;
        bf16x8 qf[4];
#pragma unroll
        for (int d0 = 0; d0 < 4; ++d0) qf[d0] = *(const bf16x8*)(Q + (rowbase + qw + r32) * DM + qcol + 16 * d0 + 8 * hi);
        float m_run, l_run;
        if (DIFF) { m_run = -1e30f; l_run = 0.f; } else { m_run = aux[h * 4 + gsub] * LOG2E; l_run = hi == 0 ? 1.f : 0.f; }
        f32x16 o[NDB];
#pragma unroll
        for (int d = 0; d < NDB; ++d)
#pragma unroll
            for (int r = 0; r < 16; ++r) o[d][r] = 0.f;
        const int NT = t1 - t0;
#define ATT_TI(i_) (DIFF ? (((i_) + rot) & 63) : (t0 + (i_)))
        const int rot = DIFF ? ((bx >> 3) * 2) & 63 : 0;
#ifdef LATE_FORCE
        const bool late = LATE_FORCE;
#else
        const bool late = wid >= 4;
#endif
        constexpr int ROWB = VD * 2;
        u32x4 st[NCH];
#define ATT_LOADX(ST, tt) do { const size_t to_ = (size_t)(tt) * 64 * PITCH; ST[0] = *(const u32x4*)(gk + to_); \
            if (DIFF) { ST[1] = *(const u32x4*)(gk + to_ + 64); ST[2] = *(const u32x4*)(gv + to_); ST[NCH - 1] = *(const u32x4*)(gv + to_ + 32 * PITCH); } else ST[1] = *(const u32x4*)(gv + to_); } while (0)
#define ATT_LOAD(tt) ATT_LOADX(st, tt)
#define ATT_WRITEX(ST, boff) do { *(LAS u32x4*)(lds + (boff) + sdk) = ST[0]; \
            if (DIFF) { *(LAS u32x4*)(lds + (boff) + sdk + 8192) = ST[1]; *(LAS u32x4*)(lds + (boff) + sdv) = ST[2]; *(LAS u32x4*)(lds + (boff) + sdv + 8192) = ST[NCH - 1]; } else *(LAS u32x4*)(lds + (boff) + sdv) = ST[1]; } while (0)
#define ATT_WRITE(boff) ATT_WRITEX(st, boff)
#define ATT_QK(P0, P1, boff, NEGB) do { const LAS unsigned char* kb_ = lds + (boff) + comp * 8192; \
            _Pragma("unroll") for (int r_ = 0; r_ < 16; ++r_) { P0[r_] = (NEGB); P1[r_] = (NEGB); } \
            _Pragma("unroll") for (int d0 = 0; d0 < 4; ++d0) { \
                const bf16x8 k0_ = *(const LAS bf16x8*)(kb_ + koff(r32, 2 * d0 + hi)), k1_ = *(const LAS bf16x8*)(kb_ + koff(32 + r32, 2 * d0 + hi)); \
                P0 = __builtin_amdgcn_mfma_f32_32x32x16_bf16(k0_, qf[d0], P0, 0, 0, 0); P1 = __builtin_amdgcn_mfma_f32_32x32x16_bf16(k1_, qf[d0], P1, 0, 0, 0); } } while (0)
#define ATT_VRD(dd, VA, boff) do { const int a0_ = (boff) + vaddr[dd], a1_ = (boff) + ((VD == 128 ? (vaddr[dd] ^ 32) : vaddr[dd]) + 8 * ROWB); \
            _Pragma("unroll") for (int kb = 0; kb < 2; ++kb) _Pragma("unroll") for (int s = 0; s < 2; ++s) { \
                VA[kb][s][0] = vtr(lds + a0_ + (32 * kb + 16 * s) * ROWB); VA[kb][s][1] = vtr(lds + a1_ + (32 * kb + 16 * s) * ROWB); } } while (0)
#define ATT_PV(dd, VA) do { _Pragma("unroll") for (int kb = 0; kb < 2; ++kb) _Pragma("unroll") for (int s = 0; s < 2; ++s) { \
            const s16x4 lo_ = VA[kb][s][0], hi_ = VA[kb][s][1]; const bf16x8 a_ = {lo_[0], lo_[1], lo_[2], lo_[3], hi_[0], hi_[1], hi_[2], hi_[3]}; \
            o[dd] = __builtin_amdgcn_mfma_f32_32x32x16_bf16(a_, pk[kb][s], o[dd], 0, 0, 0); } } while (0)
#define ATT_PVBLOCK(boff) do { ATT_VRD(1, va1, boff); __builtin_amdgcn_sched_barrier(0); ATT_PV(0, va0); \
            if (NDB > 2) { __builtin_amdgcn_sched_barrier(0); ATT_VRD(NDB > 2 ? 2 : 0, va2, boff); __builtin_amdgcn_sched_barrier(0); } \
            ATT_PV(1, va1); \
            if (NDB > 2) { __builtin_amdgcn_sched_barrier(0); ATT_VRD(NDB > 2 ? 3 : 1, va3, boff); __builtin_amdgcn_sched_barrier(0); ATT_PV(NDB > 2 ? 2 : 0, va2); ATT_PV(NDB > 2 ? 3 : 1, va3); } } while (0)
#define ATT_SM(tt) do { \
            if (!DIFF && ((tt) == qb - 2 || (tt) == qb + 2)) {     \
                const int kbase = 64 * (tt) + 4 * hi - (qw + r32); \
                _Pragma("unroll") for (int r = 0; r < 16; ++r) { const int rel = kbase + (r & 3) + 8 * (r >> 2); \
                    if (rel > 128 || rel < -128) p0[r] = -INFINITY; \
                    if (rel + 32 > 128 || rel + 32 < -128) p1[r] = -INFINITY; } } \
            float mxa = max3f_(p0[0], p0[1], p1[0]), mxb = max3f_(p0[2], p0[3], p1[1]); mxa = max3f_(mxa, p1[2], p1[3]); \
            _Pragma("unroll") for (int r = 4; r < 16; r += 4) { mxa = max3f_(mxa, p0[r], p0[r + 1]); mxb = max3f_(mxb, p0[r + 2], p0[r + 3]); mxa = max3f_(mxa, p1[r], p1[r + 1]); mxb = max3f_(mxb, p1[r + 2], p1[r + 3]); } \
            const float mx = xhalf_max(__builtin_fmaxf(mxa, mxb)) + base_p;            \
            const float m_new = __builtin_fmaxf(m_run, mx); \
            if (__any(mx - m_run > 8.0f)) {     \
                const float al = __builtin_amdgcn_exp2f(m_run - m_new); l_run *= al; \
                _Pragma("unroll") for (int d = 0; d < NDB; ++d) _Pragma("unroll") for (int r = 0; r < 16; ++r) o[d][r] *= al; \
                m_run = m_new; } \
            float ls = 0.f; \
            if (__any(m_run != base_p)) { const float sh_ = m_run - base_p; \
                _Pragma("unroll") for (int r = 0; r < 16; ++r) { p0[r] = __builtin_amdgcn_exp2f(p0[r] - sh_); p1[r] = __builtin_amdgcn_exp2f(p1[r] - sh_); ls += p0[r] + p1[r]; } \
            } else { \
                _Pragma("unroll") for (int r = 0; r < 16; ++r) { p0[r] = __builtin_amdgcn_exp2f(p0[r]); p1[r] = __builtin_amdgcn_exp2f(p1[r]); ls += p0[r] + p1[r]; } } \
            l_run += ls; \
            _Pragma("unroll") for (int s = 0; s < 2; ++s) { u32x4 w0, w1; \
                w0.x = pg8::cvt_pk_bf16(p0[8 * s + 0], p0[8 * s + 1]); w0.y = pg8::cvt_pk_bf16(p0[8 * s + 2], p0[8 * s + 3]); w0.z = pg8::cvt_pk_bf16(p0[8 * s + 4], p0[8 * s + 5]); w0.w = pg8::cvt_pk_bf16(p0[8 * s + 6], p0[8 * s + 7]); \
                w1.x = pg8::cvt_pk_bf16(p1[8 * s + 0], p1[8 * s + 1]); w1.y = pg8::cvt_pk_bf16(p1[8 * s + 2], p1[8 * s + 3]); w1.z = pg8::cvt_pk_bf16(p1[8 * s + 4], p1[8 * s + 5]); w1.w = pg8::cvt_pk_bf16(p1[8 * s + 6], p1[8 * s + 7]); \
                pk[0][s] = __builtin_bit_cast(bf16x8, w0); pk[1][s] = __builtin_bit_cast(bf16x8, w1); } } while (0)
        f32x16 p0, p1;
        bf16x8 pk[2][2];
        float base_p = 0.f, base_n = 0.f;
        if (!DIFF) {
            { u32x4 s0[NCH], s1[NCH], s2[NCH], s3[NCH], s4[NCH];
              ATT_LOADX(s0, t0); ATT_LOADX(s1, t0 + 1); ATT_LOADX(s2, t0 + 2); if (NT > 3) ATT_LOADX(s3, t0 + 3); if (NT > 4) ATT_LOADX(s4, t0 + 4);
              ATT_WRITEX(s0, 0); ATT_WRITEX(s1, BUFB); ATT_WRITEX(s2, 2 * BUFB); if (NT > 3) ATT_WRITEX(s3, 3 * BUFB); if (NT > 4) ATT_WRITEX(s4, 4 * BUFB); }
            __syncthreads();
            ATT_QK(p0, p1, 0, 0.f);
            int b_cur = 0;
            for (int i = 0; i < NT; ++i) {
                const int t = t0 + i;
                s16x4 va0[2][2][2], va1[2][2][2], va2[2][2][2], va3[2][2][2];
                f32x16 n0, n1;
                base_n = i == 0 ? 0.f : m_run;
                if (i + 1 < NT) { const float nb_ = -base_n; ATT_QK(n0, n1, b_cur + BUFB, nb_); }
                ATT_VRD(0, va0, b_cur);
                __builtin_amdgcn_sched_barrier(0);
                ATT_SM(t);
                ATT_PVBLOCK(b_cur);
                if (i + 1 < NT) { p0 = n0; p1 = n1; base_p = base_n; }
                b_cur += BUFB;
            }
        } else {
        { u32x4 sa[NCH], sb[NCH];
          ATT_LOADX(sa, ATT_TI(0)); if (NT > 1) ATT_LOADX(sb, ATT_TI(1)); if (NT > 2) ATT_LOAD(ATT_TI(2));
          ATT_WRITEX(sa, 0); if (NT > 1) ATT_WRITEX(sb, BUFB); }
        __syncthreads();
        ATT_QK(p0, p1, 0, 0.f);
        int b_prv = 3 * BUFB, b_cur = 0, b_nxt = BUFB, b_wr = 2 * BUFB;
        for (int i = 0; i < NT; ++i) {
            const int t = ATT_TI(i);
            if (i + 2 < NT) ATT_WRITE(b_wr);
            if (i + 3 < NT) ATT_LOAD(ATT_TI(i + 3));
            s16x4 va0[2][2][2], va1[2][2][2], va2[2][2][2], va3[2][2][2];
            f32x16 n0, n1;
            base_n = i == 0 ? 0.f : m_run;
            if (i + 1 < NT) { const float nb_ = -base_n; ATT_QK(n0, n1, b_nxt, nb_); }
            ATT_VRD(0, va0, b_cur);
            __builtin_amdgcn_sched_barrier(0);
            ATT_SM(t);
            if (late) __syncthreads();
            ATT_PVBLOCK(b_cur);
            if (!late) __syncthreads();
            if (i + 1 < NT) { p0 = n0; p1 = n1; base_p = base_n; }
            { const int tmp = b_prv; b_prv = b_cur; b_cur = b_nxt; b_nxt = b_wr; b_wr = tmp; }
        }
        }
        __syncthreads();
#undef ATT_LOAD
#undef ATT_TI
#undef ATT_WRITE
#undef ATT_LOADX
#undef ATT_WRITEX
#undef ATT_QK
#undef ATT_VRD
#undef ATT_PV
#undef ATT_PVBLOCK
#undef ATT_SM
        const float inv = __builtin_amdgcn_rcpf(xhalf_sum(l_run));
        bf16_t* orow = O + (rowbase + qw + r32) * DM + (DIFF ? h * 128 : (h * 4 + gsub) * 64);
        if (DIFF) {
            LAS float* xch = (LAS float*)lds + (size_t)rg * 64 * 64 + lane;
            if (comp == 1) {
#pragma unroll
                for (int d = 0; d < NDB; ++d)
#pragma unroll
                    for (int r = 0; r < 16; ++r) xch[(d * 16 + r) * 64] = o[d][r] * inv;
            }
            __syncthreads();
            if (comp == 0) {
                float ss = 0.f;
#pragma unroll
                for (int d = 0; d < NDB; ++d)
#pragma unroll
                    for (int r = 0; r < 16; ++r) { const float x = o[d][r] * inv - lam_full * xch[(d * 16 + r) * 64]; o[d][r] = x; ss += x * x; }
                ss = xhalf_sum(ss);
                const float rs = rsqrtf(ss * (1.f / 128.f) + EPS) * (1.f - lam_init);
#pragma unroll
                for (int d = 0; d < NDB; ++d)
#pragma unroll
                    for (int j = 0; j < 2; ++j) { u32x2 pc[2];
#pragma unroll
                        for (int k = 0; k < 2; ++k) { const int rq = 2 * j + k, dc = 32 * d + 8 * rq + 4 * hi; const f32x4 gn = *(const f32x4*)(subln + dc);
                            f32x4 x; x[0] = o[d][4 * rq] * rs * gn[0]; x[1] = o[d][4 * rq + 1] * rs * gn[1]; x[2] = o[d][4 * rq + 2] * rs * gn[2]; x[3] = o[d][4 * rq + 3] * rs * gn[3]; pc[k] = pack4(x); }
                        *(u32x4*)(orow + 32 * d + 16 * j + 8 * hi) = pair_swap(pc[0], pc[1]); }
            }
            __syncthreads();
        } else {
#pragma unroll
            for (int d = 0; d < NDB; ++d)
#pragma unroll
                for (int j = 0; j < 2; ++j) { u32x2 pc[2];
#pragma unroll
                    for (int k = 0; k < 2; ++k) { const int rq = 2 * j + k;
                        f32x4 x; x[0] = o[d][4 * rq] * inv; x[1] = o[d][4 * rq + 1] * inv; x[2] = o[d][4 * rq + 2] * inv; x[3] = o[d][4 * rq + 3] * inv; pc[k] = pack4(x); }
                    *(u32x4*)(orow + 32 * d + 16 * j + 8 * hi) = pair_swap(pc[0], pc[1]); }
        }
    }
}
#define XB_TMO      128
#define XB_XCNT(j)  (256  + 64 * (j))
#define XB_XSUB(j)  (1280 + 64 * (j))
#define XB_XGEN(j)  (2304 + 64 * (j))
#define XB_TOP      3328
#define XB_TOPGEN   3392
#define XCD_BAR_WORDS 3456
#define XB_SPIN_CAP (1u << 18)

__device__ __forceinline__ unsigned xb_ld(unsigned* p)              { return __hip_atomic_load(p, __ATOMIC_RELAXED, __HIP_MEMORY_SCOPE_AGENT); }
__device__ __forceinline__ unsigned xb_add(unsigned* p, unsigned v) { return __hip_atomic_fetch_add(p, v, __ATOMIC_RELAXED, __HIP_MEMORY_SCOPE_AGENT); }
__device__ __forceinline__ unsigned xb_xcc_id() { return (unsigned)__builtin_amdgcn_s_getreg((3 << 11) | 20) & 0xFu; }
#define XB_SPIN(cond, bar) do { unsigned _sp = 0; while (cond) { __builtin_amdgcn_s_sleep(1); \
    if ((++_sp & 255u) == 0u) { if (xb_ld(&(bar)[XB_TMO])) break; if (_sp > XB_SPIN_CAP) { atomicAdd(&(bar)[XB_TMO], 1u); break; } } } } while (0)

struct XcdBarrier {
    unsigned* bar; unsigned x;
    volatile LAS unsigned* st;
};

__device__ __forceinline__ XcdBarrier xcd_barrier_post(unsigned* bar, volatile LAS unsigned* st) {
    XcdBarrier b; b.bar = bar; b.x = xb_xcc_id(); b.st = st;
    if (tidx() == 0) (void)xb_add(&bar[XB_XCNT(b.x)], 1u);
    return b;
}
__device__ __forceinline__ void xcd_barrier_complete(unsigned* bar, unsigned x, unsigned& nloc, unsigned& nx) {
    const unsigned G = gridDim.x * gridDim.y * gridDim.z;
    unsigned sum, cnt, mine, sp = 0u;
    for (;;) {
        sum = 0u; cnt = 0u; mine = 0u;
#pragma unroll
        for (unsigned j = 0; j < 16; ++j) { const unsigned c = xb_ld(&bar[XB_XCNT(j)]); sum += c; cnt += (c > 0u) ? 1u : 0u; mine = (j == x) ? c : mine; }
        if (sum == G) break;
        __builtin_amdgcn_s_sleep(1);
        if ((++sp & 255u) == 0u) { if (xb_ld(&bar[XB_TMO])) break; if (sp > XB_SPIN_CAP) { atomicAdd(&bar[XB_TMO], 1u); break; } }
    }
    nloc = mine > 0u ? mine : 1u; nx = cnt > 0u ? cnt : 1u;
}

__device__ __forceinline__ void xcd_barrier(const XcdBarrier& b) {
    asm volatile("s_waitcnt vmcnt(0)" ::: "memory");
    __syncthreads();
    if (tidx() == 0) {
        unsigned* bar = b.bar;
        __builtin_amdgcn_s_waitcnt(0);
        unsigned nloc = b.st[0], nx = b.st[1];
        if (nloc == 0u) { xcd_barrier_complete(bar, b.x, nloc, nx); b.st[0] = nloc; b.st[1] = nx; }
        const unsigned old = xb_add(&bar[XB_XSUB(b.x)], 1u);
        const unsigned gen = old / nloc;
        if (old + 1u == (gen + 1u) * nloc) {
            __builtin_amdgcn_fence(__ATOMIC_RELEASE, "agent");
            asm volatile("s_waitcnt vmcnt(0)" ::: "memory");
            const unsigned og = xb_add(&bar[XB_TOP], 1u);
            const unsigned tg = og / nx;
            if (og + 1u == (tg + 1u) * nx) xb_add(&bar[XB_TOPGEN], 1u);
            else XB_SPIN(xb_ld(&bar[XB_TOPGEN]) == tg, bar);
            __builtin_amdgcn_fence(__ATOMIC_ACQUIRE, "agent");
            xb_add(&bar[XB_XGEN(b.x)], 1u);
            asm volatile("s_waitcnt vmcnt(0)" ::: "memory");
        } else {
            XB_SPIN(xb_ld(&bar[XB_XGEN(b.x)]) == gen, bar);
            __builtin_amdgcn_fence(__ATOMIC_ACQUIRE, "agent");
            asm volatile("s_waitcnt vmcnt(0)" ::: "memory");
        }
    }
    __syncthreads();
}

__device__ __forceinline__ void rms_rows_bf16(const float* src, const float* gain, bf16_t* dst) {
    int tid_ = tidx();
    const int lane = tid_ & 63, gw = bidx() * 8 + (tid_ >> 6), ngw = gdim() * 8;
    f32x4 gn[4];
#pragma unroll
    for (int j = 0; j < 4; ++j) gn[j] = ((const f32x4*)gain)[lane + 64 * j];
    for (int m = gw; m < T; m += ngw) {
        const f32x4* xr = (const f32x4*)(src + (size_t)m * DM) + lane; f32x4 v[4]; float ss = 0.f;
#pragma unroll
        for (int j = 0; j < 4; ++j) { v[j] = xr[64 * j]; ss += (v[j][0] * v[j][0] + v[j][1] * v[j][1]) + (v[j][2] * v[j][2] + v[j][3] * v[j][3]); }
        const float rs = rsqrtf(wave_sum(ss, lane) * (1.f / DM) + EPS);
        u32x2* o = (u32x2*)(dst + (size_t)m * DM) + lane;
#pragma unroll
        for (int j = 0; j < 4; ++j) o[64 * j] = pack4(v[j] * rs * gn[j]);
    }
}
__device__ __forceinline__ void x_rows_prep(const float* src, bf16_t* dst, float* SS) {
    int tid_ = tidx();
    const int lane = tid_ & 63, gw = bidx() * 8 + (tid_ >> 6), ngw = gdim() * 8;
    for (int m = 2 * gw; m < T; m += 2 * ngw) {
        const f32x4* xa = (const f32x4*)(src + (size_t)m * DM) + lane; const f32x4* xb = xa + DM / 4; f32x4 va[4], vb[4]; float sa = 0.f, sb = 0.f;
#pragma unroll
        for (int j = 0; j < 4; ++j) { va[j] = xa[64 * j]; vb[j] = xb[64 * j]; }
#pragma unroll
        for (int j = 0; j < 4; ++j) { sa += (va[j][0] * va[j][0] + va[j][1] * va[j][1]) + (va[j][2] * va[j][2] + va[j][3] * va[j][3]); sb += (vb[j][0] * vb[j][0] + vb[j][1] * vb[j][1]) + (vb[j][2] * vb[j][2] + vb[j][3] * vb[j][3]); }
        sa = wave_sum(sa, lane); sb = wave_sum(sb, lane);
        u32x2* oa = (u32x2*)(dst + (size_t)m * DM) + lane; u32x2* ob = oa + DM / 4;
#pragma unroll
        for (int j = 0; j < 4; ++j) { oa[64 * j] = pack4(va[j]); ob[64 * j] = pack4(vb[j]); }
        if (lane < 32) SS[(size_t)m * 16 + lane] = lane == 0 ? sa : lane == 16 ? sb : 0.f;
    }
}
__device__ __forceinline__ void rms_rows_final(const bf16_t* HB, const bf16_t* LO, const float* gain, float* dst) {
    int tid_ = tidx();
    const int lane = tid_ & 63, gw = bidx() * 8 + (tid_ >> 6), ngw = gdim() * 8;
    for (int m = 2 * gw; m < T; m += 2 * ngw) {
        f32x4 v[2][4]; float ss[2] = {0.f, 0.f};
#pragma unroll
        for (int r = 0; r < 2; ++r) { const u32x4* hr = (const u32x4*)(HB + (size_t)(m + r) * DM) + lane; const u32x4* lr = (const u32x4*)(LO + (size_t)(m + r) * DM) + lane;
#pragma unroll
            for (int j = 0; j < 2; ++j) { f32x4 a0, a1, l0, l1; unpack8(hr[64 * j], a0, a1); unpack8(lr[64 * j], l0, l1); v[r][2 * j] = a0 + l0; v[r][2 * j + 1] = a1 + l1; } }
#pragma unroll
        for (int r = 0; r < 2; ++r)
#pragma unroll
            for (int j = 0; j < 4; ++j) ss[r] += (v[r][j][0] * v[r][j][0] + v[r][j][1] * v[r][j][1]) + (v[r][j][2] * v[r][j][2] + v[r][j][3] * v[r][j][3]);
#pragma unroll
        for (int r = 0; r < 2; ++r) { const float rs = rsqrtf(wave_sum(ss[r], lane) * (1.f / DM) + EPS);
#pragma unroll
            for (int j = 0; j < 2; ++j) { const f32x4* gp = (const f32x4*)(gain + 512 * j + 8 * lane); f32x4* o = (f32x4*)(dst + (size_t)(m + r) * DM + 512 * j + 8 * lane);
                o[0] = v[r][2 * j] * rs * gp[0]; o[1] = v[r][2 * j + 1] * rs * gp[1]; } }
    }
}
__device__ __forceinline__ void cvt_rows_bf16(const float* src, bf16_t* dst, size_t nquads) {
    const size_t gs_ = (size_t)gdim() * 512;
    for (size_t i = (size_t)bidx() * 512 + tidx(); i < nquads; i += 4 * gs_) {
        f32x4 v[4];
#pragma unroll
        for (int k = 0; k < 4; ++k) if (i + k * gs_ < nquads) v[k] = ((const f32x4*)src)[i + k * gs_];
#pragma unroll
        for (int k = 0; k < 4; ++k) if (i + k * gs_ < nquads) ((u32x2*)dst)[i + k * gs_] = pack4(v[k]);
    }
}
template <int MAP> __device__ __forceinline__ int colmap(int g, int lim) {
    if (MAP == 1) { if (g >= lim) return g; const int tl = g >> 8, bj = (g >> 7) & 1, hw = (g >> 5) & 3, i = g & 31; return 256 * tl + 64 * hw + 32 * bj + i; }
    if (MAP == 2) { const int pn = g >> 8, bj = (g >> 7) & 1, j = g & 127; return bj * DFF + 128 * pn + j; }
    return g;
}
template <int MAP> __device__ __forceinline__ void convert_w(const float* src, const float* gain, int K, int N, bf16_t* dst, int lim, LAS float* scr, int& it, int& base) {
    int tid_ = tidx();
    const int tid = tid_, ntn = N / 256, ntiles = (K / 64) * ntn, G = gdim();
    for (; it < base + ntiles; it += G) {
        const int tile = it - base, k0 = (tile / ntn) * 64, g0 = (tile % ntn) * 256;
        { const int kk = tid >> 8, gg = tid & 255, sc = colmap<MAP>(g0 + gg, lim); float v[32];
#pragma unroll
          for (int i = 0; i < 32; ++i) v[i] = src[(size_t)(k0 + kk + 2 * i) * N + sc];
#pragma unroll
          for (int i = 0; i < 32; ++i) scr[(kk + 2 * i) * 257 + gg] = v[i] * (gain ? gain[k0 + kk + 2 * i] : 1.f); }
        __syncthreads();
#pragma unroll
        for (int j = 0; j < 4; ++j) { const int g = (tid >> 3) + 64 * j, kc = tid & 7; const LAS float* s = scr + (kc * 8) * 257 + g; u32x4 w;
          w.x = pg8::cvt_pk_bf16(s[0], s[257]); w.y = pg8::cvt_pk_bf16(s[2 * 257], s[3 * 257]); w.z = pg8::cvt_pk_bf16(s[4 * 257], s[5 * 257]); w.w = pg8::cvt_pk_bf16(s[6 * 257], s[7 * 257]);
          *(u32x4*)(dst + (size_t)(g0 + g) * K + k0 + kc * 8) = w; }
        __syncthreads();
    }
    base += ntiles;
}
__device__ __forceinline__ void rope_table(const int* pos, float* cosT, float* sinT) {
    const int gs_ = gdim() * 512;
    for (int idx = bidx() * 512 + tidx(); idx < T * 32; idx += gs_) {
        const int tok = idx >> 5, i = idx & 31;
        const float inv = exp2f(-(float)i * 0.41524101186092029f);
        const float ang = (float)pos[tok] * inv;
        const float n = rintf(ang * 0.6366197723675814f);
        float r = fmaf(n, -1.5703125f, ang); r = fmaf(n, -4.837512969970703125e-4f, r); r = fmaf(n, -7.54978995489188216e-8f, r);
        const float s = __sinf(r), c = __cosf(r); const int q = (int)n & 3;
        cosT[idx] = q == 0 ? c : q == 1 ? -s : q == 2 ? -c : s;
        sinT[idx] = q == 0 ? s : q == 1 ? c : q == 2 ? -s : -c;
    }
}

#ifndef NRUN
#define NRUN NPHASE
#endif
#ifndef PHMASK
#define PHMASK 0x7F
#endif
struct Params { const float* in[20]; float* out; unsigned char* ws; int lo, hi; };
enum { I_X = 0, I_P, I_POS, I_ATTN_NORM, I_FFN_NORM, I_PLE_NORM, I_FINAL_NORM, I_DIFF_QKV, I_DIFF_O, I_DIFF_LAM, I_DIFF_SUBLN, I_SWA_QKV, I_SWA_O, I_SWA_SINKS, I_UP, I_CONV_W, I_CONV_B, I_DOWN, I_PLE_PROJ, I_PLE_GATE };

template <class Epi> __device__ __forceinline__ void run_gemm(LAS unsigned char* lds, const bf16_t* A, const bf16_t* Bt, int N, int K, const Epi& E, int rev = 0) {
    pg8::Gemm g{A, Bt, T, N, K}; pg8::StaticOrder S; S.init(T, N, gdim(), bidx(), rev);
    pg8::gemm_phase<Epi, pg8::StaticOrder, true, true>(lds, g, S, E);
}

__global__ void __launch_bounds__(512, 2) fwd_kernel(Params P) {
    extern __shared__ __attribute__((aligned(16))) unsigned char lds_raw[];
    LAS unsigned char* lds = (LAS unsigned char*)lds_raw;
#ifdef PROBE_DUP
#ifndef PROBE_LMASK
#define PROBE_LMASK 15
#endif
    int dup_done_ = 0;
#endif
    volatile LAS unsigned* xst = (volatile LAS unsigned*)(lds + 131072);
    if (threadIdx.x < 4) xst[threadIdx.x] = 0u;
    if ((threadIdx.x & 63) == 0) *reinterpret_cast<volatile LAS int*>(TID_TBL + 4u * hw_wave_slot()) = (int)(threadIdx.x >> 6);
    __syncthreads();
    XcdBarrier xbar = xcd_barrier_post((unsigned*)(P.ws + WS_BAR), xst);
    for (int ph = P.lo; ph < P.hi; ++ph) {
        int zz = 0; asm volatile("" : "+s"(zz));
        unsigned char* ws = P.ws + zz;
        bf16_t* XN = (bf16_t*)(ws + WS_XN); bf16_t* Qb = (bf16_t*)(ws + WS_Q); bf16_t* Kb = (bf16_t*)(ws + WS_K); bf16_t* Vb = (bf16_t*)(ws + WS_V);
        bf16_t* Ob = (bf16_t*)(ws + WS_O); bf16_t* Gb = (bf16_t*)(ws + WS_G); bf16_t* ACT = (bf16_t*)(ws + WS_ACT); bf16_t* HALO = (bf16_t*)(ws + WS_HALO); bf16_t* PB = (bf16_t*)(ws + WS_PB);
        float* cosT = (float*)(ws + WS_COS); float* sinT = (float*)(ws + WS_SIN);
        bf16_t* LOb = (bf16_t*)(ws + WS_LO);
        float* SS = (float*)(ws + WS_SS);
        if (ph == 0) {
            int it = bidx(), base = 0; LAS float* scr = (LAS float*)lds;
            for (int L = 0; L < DEPTH; ++L) {
                unsigned char* wl = ws + WS_W + (size_t)L * W_LAYER; const int j = L >> 1;
                if ((L & 1) == 0) { convert_w<1>(P.in[zz + I_DIFF_QKV] + (size_t)j * DM * 3072, P.in[zz + I_ATTN_NORM] + L * DM, DM, 3072, (bf16_t*)(wl + W_QKV), 2048, scr, it, base);
                                    convert_w<0>(P.in[zz + I_DIFF_O] + (size_t)j * DM * DM, nullptr, DM, DM, (bf16_t*)(wl + W_O), 0, scr, it, base); }
                else { convert_w<1>(P.in[zz + I_SWA_QKV] + (size_t)j * DM * 1536, P.in[zz + I_ATTN_NORM] + L * DM, DM, 1536, (bf16_t*)(wl + W_QKV), 1280, scr, it, base);
                       convert_w<0>(P.in[zz + I_SWA_O] + (size_t)j * DM * DM, nullptr, DM, DM, (bf16_t*)(wl + W_O), 0, scr, it, base); }
                convert_w<2>(P.in[zz + I_UP] + (size_t)L * DM * 2 * DFF, P.in[zz + I_FFN_NORM] + L * DM, DM, 2 * DFF, (bf16_t*)(wl + W_UP), 0, scr, it, base);
                convert_w<0>(P.in[zz + I_DOWN] + (size_t)L * DFF * DM, nullptr, DFF, DM, (bf16_t*)(wl + W_DOWN), 0, scr, it, base);
                convert_w<0>(P.in[zz + I_PLE_GATE] + (size_t)L * DM * DM, P.in[zz + I_PLE_NORM] + L * DM, DM, DM, (bf16_t*)(wl + W_GATE), 0, scr, it, base);
                convert_w<0>(P.in[zz + I_PLE_PROJ] + (size_t)L * PLE * DM, nullptr, PLE, DM, (bf16_t*)(wl + W_PROJ), 0, scr, it, base);
            }
            rope_table((const int*)P.in[zz + I_POS], cosT, sinT);
            x_rows_prep(P.in[zz + I_X], XN, SS);
        } else if (ph == NPHASE - 1) {
            rms_rows_final(XN, LOb, P.in[zz + I_FINAL_NORM], P.out + zz);
        } else {
            const int L = (ph - 1) / 7, k = (ph - 1) % 7, j = L >> 1; const bool diff = (L & 1) == 0;
            unsigned char* wl = ws + WS_W + (size_t)L * W_LAYER;
            const float lam_init = L == 0 ? 0.2f : 0.47071301834f;
            if (k == 0 && (PHMASK >> 0 & 1)) {
                if (diff) { EpiQKV E{Qb, Kb, Vb, 4, 4, 1024, 1024, cosT, sinT, 0.125f * LOG2E, SS}; run_gemm(lds, XN, (const bf16_t*)(wl + W_QKV), 3072, DM, E); }
                else { EpiQKV E{Qb, Kb, Vb, 4, 1, 256, 256, cosT, sinT, 0.125f * LOG2E, SS}; run_gemm(lds, XN, (const bf16_t*)(wl + W_QKV), 1536, DM, E); }
            } else if (k == 1 && (PHMASK >> 1 & 1)) {
                if (diff) attn_phase<true>(lds, Qb, Kb, Vb, Ob, P.in[zz + I_DIFF_LAM] + j * 256, P.in[zz + I_DIFF_SUBLN] + j * 128, lam_init);
                else attn_phase<false>(lds, Qb, Kb, Vb, Ob, P.in[zz + I_SWA_SINKS] + j * 16, nullptr, 0.f);
            } else if (k == 2 && (PHMASK >> 2 & 1)) {
                if (L == 0) { EpiRes<true> E{P.in[zz + I_X], XN, LOb, SS}; run_gemm(lds, Ob, (const bf16_t*)(wl + W_O), DM, DM, E, 1); }
                else { EpiRes<false> E{nullptr, XN, LOb, SS}; run_gemm(lds, Ob, (const bf16_t*)(wl + W_O), DM, DM, E, 1); }
            } else if (k == 3 && (PHMASK >> 3 & 1)) {
                EpiUp E{ACT, HALO, P.in[zz + I_CONV_W] + (size_t)L * 6 * DFF, P.in[zz + I_CONV_B] + (size_t)L * 2 * DFF, SS}; run_gemm(lds, XN, (const bf16_t*)(wl + W_UP), 2 * DFF, DM, E);
            } else if (k == 4 && (PHMASK >> 4 & 1)) {
                { pg8::StaticOrder S; S.init(T, DM, gdim(), bidx()); Unit u; int last_pm = -1;
                  for (int i = 0; S.next(i, u); ++i) if (u.pm != last_pm) { ffn_fixup_panel(HALO, ACT, P.in[zz + I_CONV_W] + (size_t)L * 6 * DFF, P.in[zz + I_CONV_B] + (size_t)L * 2 * DFF, u.pm); last_pm = u.pm; } }
                cvt_rows_bf16(P.in[zz + I_P] + (size_t)L * T * PLE, PB, (size_t)T * PLE / 4);
                asm volatile("s_waitcnt vmcnt(0)" ::: "memory"); __syncthreads();
                EpiRes<false> E{nullptr, XN, LOb, SS}; run_gemm(lds, ACT, (const bf16_t*)(wl + W_DOWN), DM, DFF, E, 1);
            } else if (k == 5 && (PHMASK >> 5 & 1)) {
                EpiGate E{Gb, SS}; run_gemm(lds, XN, (const bf16_t*)(wl + W_GATE), DM, DM, E);
            } else if (PHMASK >> 6 & 1) {
                EpiProj E{Gb, XN, LOb, SS}; run_gemm(lds, PB, (const bf16_t*)(wl + W_PROJ), DM, PLE, E, 1);
            }
        }
#ifdef PROBE_DUP
        if (((ph == 0 && (PROBE_DUP & 0x100)) || (ph > 0 && ph < NPHASE - 1 && ((PROBE_DUP >> ((ph - 1) % 7)) & 1) && ((PROBE_LMASK >> ((ph - 1) / 7)) & 1))) && !(dup_done_)) { dup_done_ = 1; xcd_barrier(xbar); --ph; continue; }
        dup_done_ = 0;
#endif
        if (ph + 1 < P.hi) xcd_barrier(xbar); else if (ph + 1 > NPHASE) cg::this_grid().sync();
    }
}

extern "C" void kernel_launch(void* const* d_in, const int* in_sizes, int n_in, void* d_out, int out_size, void* d_ws, size_t ws_size, hipStream_t stream) {
    static int grid = 0;
    if (grid == 0) {
        if (n_in != 20 || out_size != T * DM || ws_size < WS_END) { fprintf(stderr, "kernel_launch: unexpected shapes: n_in %d out %d ws %zu\n", n_in, out_size, ws_size); grid = -1; return; }
        int dev = 0, cus = 0, per_cu = 0;
        hipGetDevice(&dev); hipDeviceGetAttribute(&cus, hipDeviceAttributeMultiprocessorCount, dev);
        hipFuncSetAttribute((const void*)fwd_kernel, hipFuncAttributeMaxDynamicSharedMemorySize, LDS_BYTES);
        hipOccupancyMaxActiveBlocksPerMultiprocessor(&per_cu, (const void*)fwd_kernel, 512, LDS_BYTES);
        if (per_cu < 1) { fprintf(stderr, "kernel_launch: occupancy query says %d blocks per CU\n", per_cu); per_cu = 1; }
        (void)hipGetLastError();
        grid = cus * per_cu;
    }
    if (grid < 0) return;
    if (hipMemsetAsync((char*)d_ws + WS_BAR, 0, XCD_BAR_WORDS * 4, stream) != hipSuccess) { fprintf(stderr, "kernel_launch: hipMemsetAsync of the barrier words failed\n"); return; }
    Params P{};
    for (int i = 0; i < 20; ++i) P.in[i] = (const float*)d_in[i];
    P.out = (float*)d_out; P.ws = (unsigned char*)d_ws;
#if MK_ONE_LAUNCH
    P.lo = 0; P.hi = NPHASE;
    void* args[] = {&P};
    hipError_t e = hipLaunchCooperativeKernel((const void*)fwd_kernel, dim3(grid), dim3(512), args, LDS_BYTES, stream);
    if (e != hipSuccess) fprintf(stderr, "cooperative launch failed: %s (grid %d)\n", hipGetErrorString(e), grid);
#else
    for (int ph = 0; ph < NRUN; ++ph) { P.lo = ph; P.hi = ph + 1; hipLaunchKernelGGL(fwd_kernel, dim3(grid), dim3(512), LDS_BYTES, stream, P); }
#endif
}
```

```cpp
#include <hip/hip_runtime.h>
#include <hip/hip_cooperative_groups.h>
#include <cstdio>
#include <cstdint>
namespace cg = cooperative_groups;
#ifndef MK_ONE_LAUNCH
#define MK_ONE_LAUNCH 1
#define LATE_FORCE false
#endif
#define TID_TBL 131136u
__device__ __forceinline__ unsigned hw_wave_slot() { return (unsigned)__builtin_amdgcn_s_getreg((5 << 11) | 4) & 63u; }
__device__ __forceinline__ int tidx() {
    const int w = *reinterpret_cast<volatile __attribute__((address_space(3))) int*>(TID_TBL + 4u * hw_wave_slot());
    unsigned ones_ = ~0u; asm volatile("" : "+s"(ones_));
    int t = w * 64 + (int)__builtin_amdgcn_mbcnt_hi(ones_, __builtin_amdgcn_mbcnt_lo(ones_, 0u));
    asm volatile("" : "+v"(t)); return t;
}
__device__ __forceinline__ int bidx() { int t = blockIdx.x; asm volatile("" : "+s"(t)); return t; }
__device__ __forceinline__ int gdim() { int t = gridDim.x; asm volatile("" : "+s"(t)); return t; }
namespace pg8 {
#define PG8_LAS __attribute__((address_space(3)))
typedef unsigned short bf16_t;
typedef short bf16x8 __attribute__((ext_vector_type(8)));
typedef float f32x4 __attribute__((ext_vector_type(4)));
typedef unsigned u32x4 __attribute__((ext_vector_type(4)));
constexpr int BM = 256, BK = 64, HALF = 128, HTB = HALF * BK * 2  , STAGE_BYTES = 8 * HTB, NXCD = 8, WGM = 8;

__host__ __device__ __forceinline__ int lds_byte(int r, int c) { const int st = (r >> 4) * 2 + (c >> 5), rr = r & 15, cc = c & 31, ob = rr * 64 + cc * 2; return st * 1024 + (ob ^ (((ob >> 9) & 1) << 5)); }
__host__ __device__ __forceinline__ void stage_rc(int b, int& R, int& C) { const int st = b / 1024, sb = b % 1024, swz = sb ^ (((sb >> 9) & 1) << 5); R = (st >> 1) * 16 + swz / 64; C = (st & 1) * 32 + (swz % 64) / 2; }
__host__ __device__ __forceinline__ int perm32(int rho) { const int n = rho >> 4, i = rho & 15; return 8 * (i >> 2) + 4 * n + (i & 3); }

struct Unit { int pm, pn; };
struct Gemm { const bf16_t* A; const bf16_t* Bt; int M, N, K; };

struct StaticOrder {
    int nM, nN, nwg, G, c;
    __host__ __device__ void init(int M, int N, int G_, int c_) { nM = M / BM; nN = N / BM; nwg = nM * nN; G = G_; c = c_; }
    __host__ __device__ bool next(int i, Unit& u) const {
        const long L = (long)i * G + c; if (L >= nwg) return false;
        int wgid = (int)L; { const int q = nwg / NXCD, r = nwg % NXCD, xcd = wgid % NXCD, off = wgid / NXCD; wgid = (xcd < r ? xcd * (q + 1) : r * (q + 1) + (xcd - r) * q) + off; }
        const int nig = WGM * nN, gid = wgid / nig, fm = gid * WGM, gsz = (nM - fm) < WGM ? (nM - fm) : WGM;
        u.pm = fm + ((wgid % nig) % gsz); u.pn = (wgid % nig) / gsz; return true;
    }
    __device__ __forceinline__ void a_ready(const Unit&) const {}
    __device__ __forceinline__ void done(const Unit&) const {}
};

typedef float f32x2_cv __attribute__((ext_vector_type(2))); typedef __bf16 bf16x2_cv __attribute__((ext_vector_type(2)));
__device__ __forceinline__ unsigned cvt_pk_bf16(float lo, float hi) { const f32x2_cv v = {lo, hi}; const bf16x2_cv b = __builtin_convertvector(v, bf16x2_cv); return __builtin_bit_cast(unsigned, b); }
typedef float f32x2 __attribute__((ext_vector_type(2)));
template <class Epi, class Sched, bool ALIGN_EPI = false, bool SP2 = false>
__device__ __forceinline__ void gemm_phase(PG8_LAS unsigned char* lds, const Gemm g, const Sched& S, const Epi& E) {
    int tid_ = tidx();
    const int tid = tid_, wid = __builtin_amdgcn_readfirstlane(tid >> 6), lane = tid & 63, wr = wid >> 2, wc = wid & 3, fr = lane & 15, fq = lane >> 4;
    const int K = g.K, nt = K / BK;
    unsigned voffA[2], voffB[2];
#pragma unroll
    for (int i = 0; i < 2; ++i) { int R, C; stage_rc(tid * 16 + i * 8192, R, C); const int Rb = Epi::PERM ? ((R & ~31) + perm32(R & 31)) : R;
        voffA[i] = (unsigned)(R * K + C) * 2u; voffB[i] = (unsigned)(Rb * K + C) * 2u; }
    const size_t kstep = (size_t)(BK * 2);
    const size_t hstep = (size_t)HALF * K * 2;
    const size_t tstep = 2 * hstep;
    const unsigned ldsw = (unsigned)wid * 1024u;
    const int aoff = lds_byte(wr * 64 + fr, fq * 8), boff = lds_byte(wc * 32 + fr, fq * 8);
#define PG8_SA(b, h) (((b) * 2 + (h)) * HTB)
#define PG8_SB(b, h) ((4 + (b) * 2 + (h)) * HTB)
#define PG8_STAGE(bufoff, gbase, voff) do { _Pragma("unroll") for (int _i = 0; _i < 2; ++_i) \
        __builtin_amdgcn_global_load_lds((const unsigned*)((const char*)(gbase) + (voff)[_i]), (PG8_LAS unsigned*)(lds + (bufoff) + ldsw + _i * 8192), 16, 0, 0); } while (0)
#define PG8_LDA(dst, b, h) do { _Pragma("unroll") for (int m = 0; m < 4; ++m) _Pragma("unroll") for (int k = 0; k < 2; ++k) dst[m][k] = *(const PG8_LAS bf16x8*)(lds + PG8_SA(b, h) + aoff + m * 2048 + k * 1024); } while (0)
#define PG8_LDB(dst, b, h) do { _Pragma("unroll") for (int n = 0; n < 2; ++n) _Pragma("unroll") for (int k = 0; k < 2; ++k) dst[n][k] = *(const PG8_LAS bf16x8*)(lds + PG8_SB(b, h) + boff + n * 2048 + k * 1024); } while (0)
#define PG8_MMA(ai, bj, At, Bt) do { __builtin_amdgcn_s_setprio(1); _Pragma("unroll") for (int m = 0; m < 4; ++m) _Pragma("unroll") for (int n = 0; n < 2; ++n) _Pragma("unroll") for (int k = 0; k < 2; ++k) \
        acc[ai][bj][m][n] = __builtin_amdgcn_mfma_f32_16x16x32_bf16(Bt[n][k], At[m][k], acc[ai][bj][m][n], 0, 0, 0); __builtin_amdgcn_s_setprio(0); } while (0)
#define PG8_WAIT_V(n) asm volatile("s_waitcnt vmcnt(" #n ")" ::: "memory")
#define PG8_WAIT_L(n) asm volatile("s_waitcnt lgkmcnt(" #n ")" ::: "memory")
#define PG8_BAR __builtin_amdgcn_s_barrier()
#define PG8_SCHED __builtin_amdgcn_sched_barrier(0)
    Unit cur, nxt; int ui = 0;
    if (!S.next(0, cur)) return;
    f32x4 acc[2][2][4][2];
#pragma unroll
    for (int a = 0; a < 2; ++a)
#pragma unroll
        for (int b = 0; b < 2; ++b)
#pragma unroll
            for (int m = 0; m < 4; ++m)
#pragma unroll
                for (int n = 0; n < 2; ++n) acc[a][b][m][n] = (f32x4){0.f, 0.f, 0.f, 0.f};
    bf16x8 At[4][2], B0[2][2], B1[2][2];
    const char* cA = (const char*)g.A + (size_t)cur.pm * tstep; const char* cB = (const char*)g.Bt + (size_t)cur.pn * tstep;
    S.a_ready(cur);
    if constexpr (SP2) {
        PG8_STAGE(PG8_SB(0, 0), cB, voffB); PG8_STAGE(PG8_SB(0, 1), cB + hstep, voffB); PG8_STAGE(PG8_SA(0, 0), cA, voffA); PG8_STAGE(PG8_SA(0, 1), cA + hstep, voffA);
        if (wr == 1) PG8_BAR;
        PG8_WAIT_V(2); PG8_BAR;
        PG8_STAGE(PG8_SB(1, 0), cB + kstep, voffB); PG8_STAGE(PG8_SA(1, 0), cA + kstep, voffA); PG8_STAGE(PG8_SB(1, 1), cB + hstep + kstep, voffB);
        PG8_WAIT_V(6); PG8_BAR;
    } else {
        PG8_STAGE(PG8_SB(0, 0), cB, voffB); PG8_STAGE(PG8_SA(0, 0), cA, voffA); PG8_STAGE(PG8_SB(0, 1), cB + hstep, voffB); PG8_STAGE(PG8_SA(0, 1), cA + hstep, voffA);
        if (wr == 1) PG8_BAR;
        PG8_WAIT_V(4); PG8_BAR;
        PG8_STAGE(PG8_SB(1, 0), cB + kstep, voffB); PG8_STAGE(PG8_SA(1, 0), cA + kstep, voffA); PG8_STAGE(PG8_SB(1, 1), cB + hstep + kstep, voffB);
        PG8_WAIT_V(6); PG8_BAR;
    }
    for (;;) {
        const bool has_next = S.next(ui + 1, nxt);
        const char* nA = has_next ? (const char*)g.A + (size_t)nxt.pm * tstep : cA; const char* nB = has_next ? (const char*)g.Bt + (size_t)nxt.pn * tstep : cB;
        for (int t = 0; t < nt; t += 2) {
            const bool last = (t == nt - 2);
            const char* a1 = cA + (size_t)(t + 1) * kstep;
            const char* a2 = last ? nA : cA + (size_t)(t + 2) * kstep; const char* b2 = last ? nB : cB + (size_t)(t + 2) * kstep;
            const char* a3 = a2 + kstep; const char* b3 = b2 + kstep;
            if (last && has_next) S.a_ready(nxt);
            if constexpr (SP2) {
            PG8_LDB(B0, 0, 0); PG8_LDB(B1, 0, 1); PG8_SCHED; PG8_LDA(At, 0, 0); PG8_STAGE(PG8_SA(1, 1), a1 + hstep, voffA);
            PG8_WAIT_V(8); PG8_WAIT_L(0); PG8_BAR; PG8_MMA(0, 0, At, B0); PG8_MMA(0, 1, At, B1); PG8_BAR; PG8_SCHED;
            PG8_LDA(At, 0, 1); PG8_STAGE(PG8_SB(0, 0), b2, voffB); PG8_STAGE(PG8_SB(0, 1), b2 + hstep, voffB); PG8_STAGE(PG8_SA(0, 0), a2, voffA);
            PG8_WAIT_V(8); PG8_WAIT_L(0); PG8_BAR; PG8_MMA(1, 0, At, B0); PG8_MMA(1, 1, At, B1); PG8_BAR; PG8_SCHED;
            PG8_LDB(B0, 1, 0); PG8_LDB(B1, 1, 1); PG8_SCHED; PG8_LDA(At, 1, 0); PG8_STAGE(PG8_SA(0, 1), a2 + hstep, voffA);
            PG8_WAIT_V(8); PG8_WAIT_L(0); PG8_BAR; PG8_MMA(0, 0, At, B0); PG8_MMA(0, 1, At, B1); PG8_BAR; PG8_SCHED;
            PG8_LDA(At, 1, 1); PG8_STAGE(PG8_SB(1, 0), b3, voffB); PG8_STAGE(PG8_SB(1, 1), b3 + hstep, voffB); PG8_STAGE(PG8_SA(1, 0), a3, voffA);
            PG8_WAIT_V(8); PG8_WAIT_L(0); PG8_BAR; PG8_MMA(1, 0, At, B0); PG8_MMA(1, 1, At, B1); PG8_BAR; PG8_SCHED;
            } else {
            PG8_LDB(B0, 0, 0); PG8_SCHED; PG8_LDA(At, 0, 0); PG8_STAGE(PG8_SA(1, 1), a1 + hstep, voffA);
            PG8_WAIT_L(8); PG8_BAR; PG8_WAIT_L(0); PG8_MMA(0, 0, At, B0); PG8_BAR; PG8_SCHED;
            PG8_LDB(B1, 0, 1); PG8_STAGE(PG8_SB(0, 0), b2, voffB);
            PG8_BAR; PG8_WAIT_L(0); PG8_MMA(0, 1, At, B1); PG8_BAR;
            PG8_LDA(At, 0, 1); PG8_STAGE(PG8_SA(0, 0), a2, voffA);
            PG8_BAR; PG8_WAIT_L(0); PG8_MMA(1, 0, At, B0); PG8_BAR; PG8_SCHED;
            PG8_STAGE(PG8_SB(0, 1), b2 + hstep, voffB);
            PG8_WAIT_V(6); PG8_BAR; PG8_MMA(1, 1, At, B1); PG8_BAR;
            PG8_LDB(B0, 1, 0); PG8_SCHED; PG8_LDA(At, 1, 0); PG8_STAGE(PG8_SA(0, 1), a2 + hstep, voffA);
            PG8_WAIT_L(8); PG8_BAR; PG8_WAIT_L(0); PG8_MMA(0, 0, At, B0); PG8_BAR; PG8_SCHED;
            PG8_LDB(B1, 1, 1); PG8_STAGE(PG8_SB(1, 0), b3, voffB);
            PG8_BAR; PG8_WAIT_L(0); PG8_MMA(0, 1, At, B1); PG8_BAR;
            PG8_LDA(At, 1, 1); PG8_STAGE(PG8_SA(1, 0), a3, voffA);
            PG8_BAR; PG8_WAIT_L(0); PG8_MMA(1, 0, At, B0); PG8_BAR; PG8_SCHED;
            PG8_STAGE(PG8_SB(1, 1), b3 + hstep, voffB);
            PG8_WAIT_V(6); PG8_BAR; PG8_MMA(1, 1, At, B1); PG8_BAR;
            }
        }
        if constexpr (ALIGN_EPI) { if (wr == 0) PG8_BAR; }
        if constexpr (!Epi::AFTER_DRAIN) { E(acc, cur, wr, wc, fr, fq); S.done(cur); }
        if (!has_next) break;
#pragma unroll
        for (int a = 0; a < 2; ++a)
#pragma unroll
            for (int b = 0; b < 2; ++b)
#pragma unroll
                for (int m = 0; m < 4; ++m)
#pragma unroll
                    for (int n = 0; n < 2; ++n) acc[a][b][m][n] = (f32x4){0.f, 0.f, 0.f, 0.f};
        cur = nxt; cA = nA; cB = nB; ++ui;
        if constexpr (ALIGN_EPI) { if (wr == 1) PG8_BAR; }
    }
    PG8_WAIT_V(0);
    if constexpr (!ALIGN_EPI) { if (wr == 0) PG8_BAR; }
    PG8_BAR;
    if constexpr (Epi::AFTER_DRAIN) { E.fused(acc, cur, wr, wc, fr, fq, lds, wid, lane); S.done(cur); }
#undef PG8_SA
#undef PG8_SB
#undef PG8_STAGE
#undef PG8_LDA
#undef PG8_LDB
#undef PG8_MMA
#undef PG8_WAIT_V
#undef PG8_WAIT_L
#undef PG8_BAR
#undef PG8_SCHED
}
}
using pg8::bf16_t; using pg8::f32x4; using pg8::bf16x8; using pg8::Unit;
#define LAS __attribute__((address_space(3)))
typedef float f32x16 __attribute__((ext_vector_type(16)));
typedef short s16x4 __attribute__((ext_vector_type(4)));
typedef unsigned u32x4 __attribute__((ext_vector_type(4)));
typedef unsigned u32x2 __attribute__((ext_vector_type(2)));

constexpr int BATCH = 8, SEQ = 4096, DM = 1024, T = BATCH * SEQ, DEPTH = 4, DFF = 2816, PLE = 256;
constexpr float EPS = 1e-6f, LOG2E = 1.4426950408889634f;
constexpr size_t MiB = 1u << 20;
constexpr size_t WS_W = 0, W_LAYER = 27 * MiB, W_QKV = 0, W_O = 6 * MiB, W_UP = 8 * MiB, W_DOWN = 19 * MiB, W_GATE = 24 * MiB + MiB / 2, W_PROJ = 26 * MiB + MiB / 2;
constexpr size_t WS_COS = 108 * MiB, WS_SIN = 112 * MiB, WS_XN = 116 * MiB, WS_Q = 180 * MiB, WS_K = 244 * MiB, WS_V = 308 * MiB, WS_ACT = WS_Q;
constexpr size_t WS_O = 372 * MiB, WS_G = WS_O, WS_HALO = WS_O  , WS_PB = 356 * MiB  ;
constexpr size_t WS_LO = 436 * MiB, WS_SS = 500 * MiB, WS_BAR = 502 * MiB, WS_END = 503 * MiB;
constexpr int LDS_BYTES = 131072 + 4096;
constexpr int NPHASE = 2 + 7 * DEPTH;

__device__ __forceinline__ float shfl_xor_l(float v, int o, int lane) { return __builtin_bit_cast(float, __builtin_amdgcn_ds_bpermute((lane ^ o) << 2, __builtin_bit_cast(int, v))); }
__device__ __forceinline__ float wave_sum(float v, int lane) {
#pragma unroll
    for (int o = 32; o >= 1; o >>= 1) v += shfl_xor_l(v, o, lane);
    return v;
}
__device__ __forceinline__ u32x2 pack4(f32x4 v) { u32x2 w; w.x = pg8::cvt_pk_bf16(v[0], v[1]); w.y = pg8::cvt_pk_bf16(v[2], v[3]); return w; }
__device__ __forceinline__ float bf2f(unsigned short b) { return __builtin_bit_cast(float, (unsigned)b << 16); }
__device__ __forceinline__ f32x4 unpack4(u32x2 w) { f32x4 r; r[0] = __builtin_bit_cast(float, w.x << 16); r[1] = __builtin_bit_cast(float, w.x & 0xffff0000u); r[2] = __builtin_bit_cast(float, w.y << 16); r[3] = __builtin_bit_cast(float, w.y & 0xffff0000u); return r; }
__device__ __forceinline__ void unpack8(u32x4 w, f32x4& a, f32x4& b_) { u32x2 l; l.x = w.x; l.y = w.y; u32x2 h_; h_.x = w.z; h_.y = w.w; a = unpack4(l); b_ = unpack4(h_); }
__device__ __forceinline__ u32x4 pack8(f32x4 a, f32x4 b_) { const u32x2 l = pack4(a), h_ = pack4(b_); u32x4 w; w.x = l.x; w.y = l.y; w.z = h_.x; w.w = h_.y; return w; }
__device__ __forceinline__ float sigmoidf_(float x) { return __builtin_amdgcn_rcpf(1.f + __builtin_amdgcn_exp2f(-x * LOG2E)); }
template <int CTRL> __device__ __forceinline__ float dppf(float v) { return __builtin_bit_cast(float, __builtin_amdgcn_update_dpp(0, __builtin_bit_cast(int, v), CTRL, 0xf, 0xf, true)); }
__device__ __forceinline__ f32x4 ror1(f32x4 v) { f32x4 r; r[0] = dppf<0x121>(v[0]); r[1] = dppf<0x121>(v[1]); r[2] = dppf<0x121>(v[2]); r[3] = dppf<0x121>(v[3]); return r; }
__device__ __forceinline__ f32x4 ror15(f32x4 v) { f32x4 r; r[0] = dppf<0x12F>(v[0]); r[1] = dppf<0x12F>(v[1]); r[2] = dppf<0x12F>(v[2]); r[3] = dppf<0x12F>(v[3]); return r; }

__device__ __forceinline__ float row_rstd(const float* SS, int row, int fr, int fq) {
    const f32x4 a = *(const f32x4*)(SS + (size_t)row * 16 + 4 * fq); float s = (a[0] + a[1]) + (a[2] + a[3]); const int ln_ = fr + 16 * fq;
    s += shfl_xor_l(s, 16, ln_); s += shfl_xor_l(s, 32, ln_);
    return rsqrtf(s * (1.f / DM) + EPS);
}
struct EpiQKV {
    static constexpr bool PERM = true, AFTER_DRAIN = false;
    bf16_t *Q, *K, *V; int nq, nk, kpitch, vpitch; const float* cosT; const float* sinT; float qscale; const float* SS;
    __device__ __forceinline__ void operator()(const f32x4 (&acc)[2][2][4][2], const Unit& u, int wr, int wc, int fr, int fq) const {
        const int pn = u.pn, row0 = u.pm * 256 + wr * 64 + fr;
        if (pn >= nq + nk) {
            const int col0 = (pn - nq - nk) * 256 + wc * 32 + 8 * fq;
#pragma unroll
            for (int ai = 0; ai < 2; ++ai)
#pragma unroll
                for (int m = 0; m < 4; ++m) { bf16_t* rp = V + (size_t)(row0 + ai * 128 + m * 16) * vpitch + col0; const float rs = row_rstd(SS, row0 + ai * 128 + m * 16, fr, fq);
#pragma unroll
                    for (int bj = 0; bj < 2; ++bj) { const u32x2 w0 = pack4(acc[ai][bj][m][0] * rs), w1 = pack4(acc[ai][bj][m][1] * rs); u32x4 w; w.x = w0.x; w.y = w0.y; w.z = w1.x; w.w = w1.y; *(u32x4*)(rp + bj * 128) = w; } }
        } else {
            const bool isq = pn < nq; bf16_t* base = isq ? Q : K; const int pitch = isq ? DM : kpitch, ct = (isq ? pn : pn - nq) * 256;
            const float sc = isq ? qscale : 1.f; const int ri = 8 * fq, hc = ct + 64 * wc + ri;
#pragma unroll
            for (int ai = 0; ai < 2; ++ai)
#pragma unroll
                for (int m = 0; m < 4; ++m) { const int row = row0 + ai * 128 + m * 16; const float scr_ = sc * row_rstd(SS, row, fr, fq);
                    const float* cp = cosT + (size_t)row * 32 + ri; const float* sp = sinT + (size_t)row * 32 + ri;
                    const f32x4 c0 = *(const f32x4*)cp * scr_, c1 = *(const f32x4*)(cp + 4) * scr_, s0 = *(const f32x4*)sp * scr_, s1 = *(const f32x4*)(sp + 4) * scr_;
                    const f32x4 xa0 = acc[ai][0][m][0], xa1 = acc[ai][0][m][1], xb0 = acc[ai][1][m][0], xb1 = acc[ai][1][m][1];
                    const u32x2 p0 = pack4(xa0 * c0 - xb0 * s0), p1 = pack4(xa1 * c1 - xb1 * s1), q0 = pack4(xb0 * c0 + xa0 * s0), q1 = pack4(xb1 * c1 + xa1 * s1);
                    bf16_t* dst = base + (size_t)row * pitch + hc; u32x4 w;
                    w.x = p0.x; w.y = p0.y; w.z = p1.x; w.w = p1.y; *(u32x4*)dst = w;
                    w.x = q0.x; w.y = q0.y; w.z = q1.x; w.w = q1.y; *(u32x4*)(dst + 32) = w; }
        }
    }
};
template <bool XIN> struct EpiRes {
    static constexpr bool PERM = true, AFTER_DRAIN = false;
    const float* xin; bf16_t* HB; bf16_t* LO; float* SS;
    __device__ __forceinline__ void operator()(const f32x4 (&acc)[2][2][4][2], const Unit& u, int wr, int wc, int fr, int fq) const {
        const int col0 = u.pn * 256 + wc * 32 + 8 * fq, row0 = u.pm * 256 + wr * 64 + fr;
#pragma unroll
        for (int ai = 0; ai < 2; ++ai)
#pragma unroll
            for (int m = 0; m < 4; ++m) { const int row = row0 + ai * 128 + m * 16; const size_t off = (size_t)row * DM + col0; float ss = 0.f;
#pragma unroll
                for (int bj = 0; bj < 2; ++bj) { const size_t o = off + bj * 128; f32x4 v0, v1;
                    if (XIN) { v0 = *(const f32x4*)(xin + o); v1 = *(const f32x4*)(xin + o + 4); }
                    else { f32x4 a0, a1, l0, l1; unpack8(*(const u32x4*)(HB + o), a0, a1); unpack8(*(const u32x4*)(LO + o), l0, l1); v0 = a0 + l0; v1 = a1 + l1; }
                    v0 += acc[ai][bj][m][0]; v1 += acc[ai][bj][m][1];
                    const u32x4 w = pack8(v0, v1); f32x4 r0, r1; unpack8(w, r0, r1);
                    *(u32x4*)(HB + o) = w; *(u32x4*)(LO + o) = pack8(v0 - r0, v1 - r1);
                    ss += ((v0[0] * v0[0] + v0[1] * v0[1]) + (v0[2] * v0[2] + v0[3] * v0[3])) + ((v1[0] * v1[0] + v1[1] * v1[1]) + (v1[2] * v1[2] + v1[3] * v1[3])); }
                { const int ln_ = fr + 16 * fq; ss += shfl_xor_l(ss, 16, ln_); ss += shfl_xor_l(ss, 32, ln_); }
                if (fq == 0) SS[(size_t)row * 16 + u.pn * 4 + wc] = ss;
                }
    }
};
struct EpiGate {
    static constexpr bool PERM = true, AFTER_DRAIN = false;
    bf16_t* G; const float* SS;
    __device__ __forceinline__ void operator()(const f32x4 (&acc)[2][2][4][2], const Unit& u, int wr, int wc, int fr, int fq) const {
        const int col0 = u.pn * 256 + wc * 32 + 8 * fq, row0 = u.pm * 256 + wr * 64 + fr;
#pragma unroll
        for (int ai = 0; ai < 2; ++ai)
#pragma unroll
            for (int m = 0; m < 4; ++m) { const size_t off = (size_t)(row0 + ai * 128 + m * 16) * DM + col0; const float rs = row_rstd(SS, row0 + ai * 128 + m * 16, fr, fq);
#pragma unroll
                for (int bj = 0; bj < 2; ++bj) { const f32x4 a0 = acc[ai][bj][m][0] * rs, a1 = acc[ai][bj][m][1] * rs; f32x4 s0, s1;
                    s0[0] = sigmoidf_(a0[0]); s0[1] = sigmoidf_(a0[1]); s0[2] = sigmoidf_(a0[2]); s0[3] = sigmoidf_(a0[3]); s1[0] = sigmoidf_(a1[0]); s1[1] = sigmoidf_(a1[1]); s1[2] = sigmoidf_(a1[2]); s1[3] = sigmoidf_(a1[3]);
                    const u32x2 w0 = pack4(s0), w1 = pack4(s1); u32x4 w; w.x = w0.x; w.y = w0.y; w.z = w1.x; w.w = w1.y; *(u32x4*)(G + off + bj * 128) = w; } }
    }
};
struct EpiProj {
    static constexpr bool PERM = true, AFTER_DRAIN = false;
    const bf16_t* G; bf16_t* HB; bf16_t* LO; float* SS;
    __device__ __forceinline__ void operator()(const f32x4 (&acc)[2][2][4][2], const Unit& u, int wr, int wc, int fr, int fq) const {
        const int col0 = u.pn * 256 + wc * 32 + 8 * fq, row0 = u.pm * 256 + wr * 64 + fr;
#pragma unroll
        for (int ai = 0; ai < 2; ++ai)
#pragma unroll
            for (int m = 0; m < 4; ++m) { const int row = row0 + ai * 128 + m * 16; const size_t off = (size_t)row * DM + col0; float ss = 0.f;
#pragma unroll
                for (int bj = 0; bj < 2; ++bj) { const size_t o = off + bj * 128; f32x4 g0, g1, a0, a1, l0, l1;
                    unpack8(*(const u32x4*)(G + o), g0, g1); unpack8(*(const u32x4*)(HB + o), a0, a1); unpack8(*(const u32x4*)(LO + o), l0, l1);
                    const f32x4 v0 = (a0 + l0) + acc[ai][bj][m][0] * g0, v1 = (a1 + l1) + acc[ai][bj][m][1] * g1;
                    const u32x4 w = pack8(v0, v1); f32x4 r0, r1; unpack8(w, r0, r1);
                    *(u32x4*)(HB + o) = w; *(u32x4*)(LO + o) = pack8(v0 - r0, v1 - r1);
                    ss += ((v0[0] * v0[0] + v0[1] * v0[1]) + (v0[2] * v0[2] + v0[3] * v0[3])) + ((v1[0] * v1[0] + v1[1] * v1[1]) + (v1[2] * v1[2] + v1[3] * v1[3])); }
                { const int ln_ = fr + 16 * fq; ss += shfl_xor_l(ss, 16, ln_); ss += shfl_xor_l(ss, 32, ln_); }
                if (fq == 0) SS[(size_t)row * 16 + u.pn * 4 + wc] = ss;
                }
    }
};
struct EpiUp {
    static constexpr bool PERM = false, AFTER_DRAIN = false;
    bf16_t* ACT; bf16_t* HALO; const float* cw; const float* cb; const float* SS;
    __device__ __forceinline__ void operator()(const f32x4 (&acc)[2][2][4][2], const Unit& u, int wr, int wc, int fr, int fq) const {
        float rs[2][4];
#pragma unroll
        for (int ai = 0; ai < 2; ++ai) {
#pragma unroll
            for (int m = 0; m < 4; ++m) rs[ai][m] = row_rstd(SS, u.pm * 256 + ai * 128 + wr * 64 + m * 16 + fr, fr, fq); }
#pragma unroll
        for (int n = 0; n < 2; ++n) {
            const int c0 = u.pn * 128 + wc * 32 + n * 16 + 4 * fq;
            const f32x4 g0 = *(const f32x4*)(cw + c0), g1 = *(const f32x4*)(cw + 2 * DFF + c0), g2 = *(const f32x4*)(cw + 4 * DFF + c0), gb = *(const f32x4*)(cb + c0);
            const f32x4 v0 = *(const f32x4*)(cw + DFF + c0), v1 = *(const f32x4*)(cw + 3 * DFF + c0), v2 = *(const f32x4*)(cw + 5 * DFF + c0), vb = *(const f32x4*)(cb + DFF + c0);
#pragma unroll
            for (int ai = 0; ai < 2; ++ai) {
                const int grp = 4 * u.pm + 2 * ai + wr;
                f32x4 Gs[4], Vs[4];
#pragma unroll
                for (int m = 0; m < 4; ++m) { Gs[m] = acc[ai][0][m][n] * rs[ai][m]; Vs[m] = acc[ai][1][m][n] * rs[ai][m]; }
#pragma unroll
                for (int m = 0; m < 4; ++m) {
                    const f32x4 g = Gs[m], v = Vs[m];
                    f32x4 gp = ror1(g), gn = ror15(g), vp = ror1(v), vn = ror15(v);
                    if (m > 0) { const f32x4 tg = ror1(Gs[m > 0 ? m - 1 : 0]), tv = ror1(Vs[m > 0 ? m - 1 : 0]); if (fr == 0) { gp = tg; vp = tv; } }
                    if (m < 3) { const f32x4 tg = ror15(Gs[m < 3 ? m + 1 : 3]), tv = ror15(Vs[m < 3 ? m + 1 : 3]); if (fr == 15) { gn = tg; vn = tv; } }
                    const f32x4 gg = g0 * gp + g1 * g + g2 * gn + gb, vv = v0 * vp + v1 * v + v2 * vn + vb;
                    f32x4 a; a[0] = gg[0] * sigmoidf_(gg[0]) * vv[0]; a[1] = gg[1] * sigmoidf_(gg[1]) * vv[1]; a[2] = gg[2] * sigmoidf_(gg[2]) * vv[2]; a[3] = gg[3] * sigmoidf_(gg[3]) * vv[3];
                    const int row = u.pm * 256 + ai * 128 + wr * 64 + m * 16 + fr;
                    const bool edge = (m == 0 && fr == 0) || (m == 3 && fr == 15);
                    if (!edge) *(u32x2*)(ACT + (size_t)row * DFF + c0) = pack4(a);
                    if (m == 0 && fr < 2) { bf16_t* hp = HALO + (size_t)(grp * 4 + fr) * (2 * DFF) + c0; *(u32x2*)hp = pack4(g); *(u32x2*)(hp + DFF) = pack4(v); }
                    if (m == 3 && fr >= 14) { bf16_t* hp = HALO + (size_t)(grp * 4 + fr - 12) * (2 * DFF) + c0; *(u32x2*)hp = pack4(g); *(u32x2*)(hp + DFF) = pack4(v); }
                    __builtin_amdgcn_sched_barrier(0);
                }
            }
        }
    }
};
__device__ __forceinline__ void ffn_fixup_panel(const bf16_t* HALO, bf16_t* ACT, const float* cw, const float* cb, int pm) {
    constexpr int NQ = DFF / 4;
    const bool no_first = (pm & 15) == 0, no_last = (pm & 15) == 15;
    for (int cq = tidx(); cq < NQ; cq += 512) {
        const int c0 = cq * 4; const bf16_t* hb = HALO + (size_t)(16 * pm - 1) * (2 * DFF) + c0;
        u32x2 Hg[18], Hv[18];
#pragma unroll
        for (int k = 0; k < 18; ++k) { const bool ok = !(k == 0 && no_first) && !(k == 17 && no_last); const u32x2 z = {0u, 0u};
            Hg[k] = ok ? *(const u32x2*)(hb + (size_t)k * (2 * DFF)) : z; Hv[k] = ok ? *(const u32x2*)(hb + (size_t)k * (2 * DFF) + DFF) : z; }
        const f32x4 g0 = *(const f32x4*)(cw + c0), g1 = *(const f32x4*)(cw + 2 * DFF + c0), g2 = *(const f32x4*)(cw + 4 * DFF + c0), gb = *(const f32x4*)(cb + c0);
        const f32x4 v0 = *(const f32x4*)(cw + DFF + c0), v1 = *(const f32x4*)(cw + 3 * DFF + c0), v2 = *(const f32x4*)(cw + 5 * DFF + c0), vb = *(const f32x4*)(cb + DFF + c0);
#pragma unroll
        for (int r = 0; r < 8; ++r) { const int g = r >> 1, last = r & 1, hb_ = 4 * g + 3 * last, t = (4 * pm + g) * 64 + 63 * last;
            const f32x4 gg = g0 * unpack4(Hg[hb_]) + g1 * unpack4(Hg[hb_ + 1]) + g2 * unpack4(Hg[hb_ + 2]) + gb, vv = v0 * unpack4(Hv[hb_]) + v1 * unpack4(Hv[hb_ + 1]) + v2 * unpack4(Hv[hb_ + 2]) + vb;
            f32x4 a; a[0] = gg[0] * sigmoidf_(gg[0]) * vv[0]; a[1] = gg[1] * sigmoidf_(gg[1]) * vv[1]; a[2] = gg[2] * sigmoidf_(gg[2]) * vv[2]; a[3] = gg[3] * sigmoidf_(gg[3]) * vv[3];
            *(u32x2*)(ACT + (size_t)t * DFF + c0) = pack4(a); }
    }
}
__device__ __forceinline__ int crow(int r, int hi) { return (r & 3) + 8 * (r >> 2) + 4 * hi; }
__device__ __forceinline__ int koff(int row, int ch) { return row * 128 + 16 * (ch ^ ((row >> 1) & 7)); }
template <int VD> __device__ __forceinline__ int voff(int row, int ch) {
    if (VD == 128) return row * 256 + 16 * (ch ^ (((row & 3) << 2) | ((row >> 2) & 3)));
    return row * 128 + 16 * (ch ^ (((row & 3) << 1) | ((row >> 2) & 1)));
}
__device__ __forceinline__ float xhalf_max(float m) { auto rr = __builtin_amdgcn_permlane32_swap(__float_as_uint(m), __float_as_uint(m), false, false); return fmaxf(__uint_as_float(rr[0]), __uint_as_float(rr[1])); }
__device__ __forceinline__ float xhalf_sum(float m) { auto rr = __builtin_amdgcn_permlane32_swap(__float_as_uint(m), __float_as_uint(m), false, false); return __uint_as_float(rr[0]) + __uint_as_float(rr[1]); }
__device__ __forceinline__ float max3f_(float a, float b, float c) { float r; asm("v_max3_f32 %0, %1, %2, %3" : "=v"(r) : "v"(a), "v"(b), "v"(c)); return r; }
__device__ __forceinline__ u32x4 pair_swap(u32x2 a, u32x2 b) {
    auto s0 = __builtin_amdgcn_permlane32_swap(a.x, b.x, false, false); auto s1 = __builtin_amdgcn_permlane32_swap(a.y, b.y, false, false);
    u32x4 w; w.x = s0[0]; w.y = s1[0]; w.z = s0[1]; w.w = s1[1]; return w;
}
typedef short v4i16_t __attribute__((ext_vector_type(4)));
__device__ __forceinline__ s16x4 vtr(const LAS unsigned char* p) { return __builtin_bit_cast(s16x4, __builtin_amdgcn_ds_read_tr16_b64_v4i16((LAS v4i16_t*)p)); }

template <bool DIFF>
__device__ __forceinline__ void attn_phase(LAS unsigned char* lds, const bf16_t* Q, const bf16_t* K, const bf16_t* V, bf16_t* O, const float* aux, const float* subln, float lam_init) {
    constexpr int VD = DIFF ? 128 : 64, NKT = DIFF ? 2 : 1, PITCH = DIFF ? 1024 : 256;
    constexpr int BUFB = NKT * 8192 + 64 * VD * 2, NDB = VD / 32, QROWS = DIFF ? 128 : 64, NCH = DIFF ? 4 : 2, NH = DIFF ? 8 : 4;
    int tid_ = tidx();
    const int tid = tid_, lane = tid & 63, wid = __builtin_amdgcn_readfirstlane(tid >> 6), r32 = lane & 31, hi = lane >> 5;
    const int rg = DIFF ? (wid >> 1) : (wid & 1), comp = DIFF ? (wid & 1) : 0, gsub = DIFF ? 0 : (wid >> 1);
    float lam_full = 0.f;
    if (DIFF) { float a = aux[lane] * aux[64 + lane], b = aux[128 + lane] * aux[192 + lane]; a = wave_sum(a, lane); b = wave_sum(b, lane); lam_full = __builtin_bit_cast(float, __builtin_amdgcn_readfirstlane(__builtin_bit_cast(int, expf(a) - expf(b) + lam_init))); }
    const int krow = tid >> 3, kch = tid & 7, vrow = DIFF ? (tid >> 4) : (tid >> 3), vch = DIFF ? (tid & 15) : (tid & 7);
    const int sdk = koff(krow, kch), sdv = NKT * 8192 + voff<VD>(vrow, vch);
    const int q_ = (lane & 15) >> 2, p_ = lane & 3, g1 = (lane >> 4) & 1;
    int vaddr[NDB];
#pragma unroll
    for (int d = 0; d < NDB; ++d) vaddr[d] = NKT * 8192 + voff<VD>(4 * hi + q_, 4 * d + 2 * g1 + (p_ >> 1)) + 8 * (p_ & 1);
    const int G = gdim(), bx = bidx();
    for (int it = 0;; ++it) {
        int pair, qb;
        if (G == 256) { if (it >= 8) break; if (DIFF) { pair = (bx & 7) + 8 * it; qb = bx >> 3; } else { pair = (bx & 7) + 8 * (it >> 1); qb = (bx >> 3) + 32 * (it & 1); } }
        else { const int u = it * G + bx; if (u >= 2048) break; if (DIFF) { pair = u >> 5; qb = u & 31; } else { pair = u >> 6; qb = u & 63; } }
        const int b = pair / NH, h = pair % NH;
        const size_t rowbase = (size_t)b * SEQ; const int q0 = qb * QROWS, qw = q0 + 32 * rg;
        const int qcol = DIFF ? (2 * h + comp) * 64 : (h * 4 + gsub) * 64;
        const int t0 = DIFF ? 0 : (qb - 2 < 0 ? 0 : qb - 2), t1 = DIFF ? 64 : (qb + 3 > 64 ? 64 : qb + 3);
        int tu_ = tid; asm volatile("" : "+v"(tu_));
        const unsigned kel = (unsigned)((tu_ >> 3) * PITCH + (tu_ & 7) * 8), vel = DIFF ? (unsigned)((tu_ >> 4) * PITCH + (tu_ & 15) * 8) : kel;
        const bf16_t* gk = (K + rowbase * PITCH + (DIFF ? (2 * h) * 64 : h * 64)) + kel;
        const bf16_t* gv = (V + rowbase * PITCH + h * VD) + vel;
        bf16x8 qf[4];
#pragma unroll
        for (int d0 = 0; d0 < 4; ++d0) qf[d0] = *(const bf16x8*)(Q + (rowbase + qw + r32) * DM + qcol + 16 * d0 + 8 * hi);
        float m_run, l_run;
        if (DIFF) { m_run = -1e30f; l_run = 0.f; } else { m_run = aux[h * 4 + gsub] * LOG2E; l_run = hi == 0 ? 1.f : 0.f; }
        f32x16 o[NDB];
#pragma unroll
        for (int d = 0; d < NDB; ++d)
#pragma unroll
            for (int r = 0; r < 16; ++r) o[d][r] = 0.f;
        const int NT = t1 - t0;
#define ATT_TI(i_) (DIFF ? (((i_) + rot) & 63) : (t0 + (i_)))
        const int rot = DIFF ? ((bx >> 3) * 2) & 63 : 0;
#ifdef LATE_FORCE
        const bool late = LATE_FORCE;
#else
        const bool late = wid >= 4;
#endif
        constexpr int ROWB = VD * 2;
        u32x4 st[NCH];
#define ATT_LOADX(ST, tt) do { const size_t to_ = (size_t)(tt) * 64 * PITCH; ST[0] = *(const u32x4*)(gk + to_); \
            if (DIFF) { ST[1] = *(const u32x4*)(gk + to_ + 64); ST[2] = *(const u32x4*)(gv + to_); ST[NCH - 1] = *(const u32x4*)(gv + to_ + 32 * PITCH); } else ST[1] = *(const u32x4*)(gv + to_); } while (0)
#define ATT_LOAD(tt) ATT_LOADX(st, tt)
#define ATT_WRITEX(ST, boff) do { *(LAS u32x4*)(lds + (boff) + sdk) = ST[0]; \
            if (DIFF) { *(LAS u32x4*)(lds + (boff) + sdk + 8192) = ST[1]; *(LAS u32x4*)(lds + (boff) + sdv) = ST[2]; *(LAS u32x4*)(lds + (boff) + sdv + 8192) = ST[NCH - 1]; } else *(LAS u32x4*)(lds + (boff) + sdv) = ST[1]; } while (0)
#define ATT_WRITE(boff) ATT_WRITEX(st, boff)
#define ATT_QK(P0, P1, boff, NEGB) do { const LAS unsigned char* kb_ = lds + (boff) + comp * 8192; \
            _Pragma("unroll") for (int r_ = 0; r_ < 16; ++r_) { P0[r_] = (NEGB); P1[r_] = (NEGB); } \
            _Pragma("unroll") for (int d0 = 0; d0 < 4; ++d0) { \
                const bf16x8 k0_ = *(const LAS bf16x8*)(kb_ + koff(r32, 2 * d0 + hi)), k1_ = *(const LAS bf16x8*)(kb_ + koff(32 + r32, 2 * d0 + hi)); \
                P0 = __builtin_amdgcn_mfma_f32_32x32x16_bf16(k0_, qf[d0], P0, 0, 0, 0); P1 = __builtin_amdgcn_mfma_f32_32x32x16_bf16(k1_, qf[d0], P1, 0, 0, 0); } } while (0)
#define ATT_VRD(dd, VA, boff) do { const int a0_ = (boff) + vaddr[dd], a1_ = (boff) + ((VD == 128 ? (vaddr[dd] ^ 32) : vaddr[dd]) + 8 * ROWB); \
            _Pragma("unroll") for (int kb = 0; kb < 2; ++kb) _Pragma("unroll") for (int s = 0; s < 2; ++s) { \
                VA[kb][s][0] = vtr(lds + a0_ + (32 * kb + 16 * s) * ROWB); VA[kb][s][1] = vtr(lds + a1_ + (32 * kb + 16 * s) * ROWB); } } while (0)
#define ATT_PV(dd, VA) do { _Pragma("unroll") for (int kb = 0; kb < 2; ++kb) _Pragma("unroll") for (int s = 0; s < 2; ++s) { \
            const s16x4 lo_ = VA[kb][s][0], hi_ = VA[kb][s][1]; const bf16x8 a_ = {lo_[0], lo_[1], lo_[2], lo_[3], hi_[0], hi_[1], hi_[2], hi_[3]}; \
            o[dd] = __builtin_amdgcn_mfma_f32_32x32x16_bf16(a_, pk[kb][s], o[dd], 0, 0, 0); } } while (0)
#define ATT_PVBLOCK(boff) do { ATT_VRD(1, va1, boff); __builtin_amdgcn_sched_barrier(0); ATT_PV(0, va0); \
            if (NDB > 2) { __builtin_amdgcn_sched_barrier(0); ATT_VRD(NDB > 2 ? 2 : 0, va2, boff); __builtin_amdgcn_sched_barrier(0); } \
            ATT_PV(1, va1); \
            if (NDB > 2) { __builtin_amdgcn_sched_barrier(0); ATT_VRD(NDB > 2 ? 3 : 1, va3, boff); __builtin_amdgcn_sched_barrier(0); ATT_PV(NDB > 2 ? 2 : 0, va2); ATT_PV(NDB > 2 ? 3 : 1, va3); } } while (0)
#define ATT_SM(tt) do { \
            if (!DIFF && ((tt) == qb - 2 || (tt) == qb + 2)) {     \
                const int kbase = 64 * (tt) + 4 * hi - (qw + r32); \
                _Pragma("unroll") for (int r = 0; r < 16; ++r) { const int rel = kbase + (r & 3) + 8 * (r >> 2); \
                    if (rel > 128 || rel < -128) p0[r] = -INFINITY; \
                    if (rel + 32 > 128 || rel + 32 < -128) p1[r] = -INFINITY; } } \
            float mxa = max3f_(p0[0], p0[1], p1[0]), mxb = max3f_(p0[2], p0[3], p1[1]); mxa = max3f_(mxa, p1[2], p1[3]); \
            _Pragma("unroll") for (int r = 4; r < 16; r += 4) { mxa = max3f_(mxa, p0[r], p0[r + 1]); mxb = max3f_(mxb, p0[r + 2], p0[r + 3]); mxa = max3f_(mxa, p1[r], p1[r + 1]); mxb = max3f_(mxb, p1[r + 2], p1[r + 3]); } \
            const float mx = xhalf_max(__builtin_fmaxf(mxa, mxb)) + base_p;            \
            const float m_new = __builtin_fmaxf(m_run, mx); \
            if (__any(mx - m_run > 8.0f)) {     \
                const float al = __builtin_amdgcn_exp2f(m_run - m_new); l_run *= al; \
                _Pragma("unroll") for (int d = 0; d < NDB; ++d) _Pragma("unroll") for (int r = 0; r < 16; ++r) o[d][r] *= al; \
                m_run = m_new; } \
            float ls = 0.f; \
            if (__any(m_run != base_p)) { const float sh_ = m_run - base_p; \
                _Pragma("unroll") for (int r = 0; r < 16; ++r) { p0[r] = __builtin_amdgcn_exp2f(p0[r] - sh_); p1[r] = __builtin_amdgcn_exp2f(p1[r] - sh_); ls += p0[r] + p1[r]; } \
            } else { \
                _Pragma("unroll") for (int r = 0; r < 16; ++r) { p0[r] = __builtin_amdgcn_exp2f(p0[r]); p1[r] = __builtin_amdgcn_exp2f(p1[r]); ls += p0[r] + p1[r]; } } \
            l_run += ls; \
            _Pragma("unroll") for (int s = 0; s < 2; ++s) { u32x4 w0, w1; \
                w0.x = pg8::cvt_pk_bf16(p0[8 * s + 0], p0[8 * s + 1]); w0.y = pg8::cvt_pk_bf16(p0[8 * s + 2], p0[8 * s + 3]); w0.z = pg8::cvt_pk_bf16(p0[8 * s + 4], p0[8 * s + 5]); w0.w = pg8::cvt_pk_bf16(p0[8 * s + 6], p0[8 * s + 7]); \
                w1.x = pg8::cvt_pk_bf16(p1[8 * s + 0], p1[8 * s + 1]); w1.y = pg8::cvt_pk_bf16(p1[8 * s + 2], p1[8 * s + 3]); w1.z = pg8::cvt_pk_bf16(p1[8 * s + 4], p1[8 * s + 5]); w1.w = pg8::cvt_pk_bf16(p1[8 * s + 6], p1[8 * s + 7]); \
                pk[0][s] = __builtin_bit_cast(bf16x8, w0); pk[1][s] = __builtin_bit_cast(bf16x8, w1); } } while (0)
        f32x16 p0, p1;
        bf16x8 pk[2][2];
        float base_p = 0.f, base_n = 0.f;
        if (!DIFF) {
            { u32x4 s0[NCH], s1[NCH], s2[NCH], s3[NCH], s4[NCH];
              ATT_LOADX(s0, t0); ATT_LOADX(s1, t0 + 1); ATT_LOADX(s2, t0 + 2); if (NT > 3) ATT_LOADX(s3, t0 + 3); if (NT > 4) ATT_LOADX(s4, t0 + 4);
              ATT_WRITEX(s0, 0); ATT_WRITEX(s1, BUFB); ATT_WRITEX(s2, 2 * BUFB); if (NT > 3) ATT_WRITEX(s3, 3 * BUFB); if (NT > 4) ATT_WRITEX(s4, 4 * BUFB); }
            __syncthreads();
            ATT_QK(p0, p1, 0, 0.f);
            int b_cur = 0;
            for (int i = 0; i < NT; ++i) {
                const int t = t0 + i;
                s16x4 va0[2][2][2], va1[2][2][2], va2[2][2][2], va3[2][2][2];
                f32x16 n0, n1;
                base_n = i == 0 ? 0.f : m_run;
                if (i + 1 < NT) { const float nb_ = -base_n; ATT_QK(n0, n1, b_cur + BUFB, nb_); }
                ATT_VRD(0, va0, b_cur);
                __builtin_amdgcn_sched_barrier(0);
                ATT_SM(t);
                ATT_PVBLOCK(b_cur);
                if (i + 1 < NT) { p0 = n0; p1 = n1; base_p = base_n; }
                b_cur += BUFB;
            }
        } else {
        { u32x4 sa[NCH], sb[NCH];
          ATT_LOADX(sa, ATT_TI(0)); if (NT > 1) ATT_LOADX(sb, ATT_TI(1)); if (NT > 2) ATT_LOAD(ATT_TI(2));
          ATT_WRITEX(sa, 0); if (NT > 1) ATT_WRITEX(sb, BUFB); }
        __syncthreads();
        ATT_QK(p0, p1, 0, 0.f);
        int b_prv = 3 * BUFB, b_cur = 0, b_nxt = BUFB, b_wr = 2 * BUFB;
        for (int i = 0; i < NT; ++i) {
            const int t = ATT_TI(i);
            if (i + 2 < NT) ATT_WRITE(b_wr);
            if (i + 3 < NT) ATT_LOAD(ATT_TI(i + 3));
            s16x4 va0[2][2][2], va1[2][2][2], va2[2][2][2], va3[2][2][2];
            f32x16 n0, n1;
            base_n = i == 0 ? 0.f : m_run;
            if (i + 1 < NT) { const float nb_ = -base_n; ATT_QK(n0, n1, b_nxt, nb_); }
            ATT_VRD(0, va0, b_cur);
            __builtin_amdgcn_sched_barrier(0);
            ATT_SM(t);
            if (late) __syncthreads();
            ATT_PVBLOCK(b_cur);
            if (!late) __syncthreads();
            if (i + 1 < NT) { p0 = n0; p1 = n1; base_p = base_n; }
            { const int tmp = b_prv; b_prv = b_cur; b_cur = b_nxt; b_nxt = b_wr; b_wr = tmp; }
        }
        }
        __syncthreads();
#undef ATT_LOAD
#undef ATT_TI
#undef ATT_WRITE
#undef ATT_LOADX
#undef ATT_WRITEX
#undef ATT_QK
#undef ATT_VRD
#undef ATT_PV
#undef ATT_PVBLOCK
#undef ATT_SM
        const float inv = __builtin_amdgcn_rcpf(xhalf_sum(l_run));
        bf16_t* orow = O + (rowbase + qw + r32) * DM + (DIFF ? h * 128 : (h * 4 + gsub) * 64);
        if (DIFF) {
            LAS float* xch = (LAS float*)lds + (size_t)rg * 64 * 64 + lane;
            if (comp == 1) {
#pragma unroll
                for (int d = 0; d < NDB; ++d)
#pragma unroll
                    for (int r = 0; r < 16; ++r) xch[(d * 16 + r) * 64] = o[d][r] * inv;
            }
            __syncthreads();
            if (comp == 0) {
                float ss = 0.f;
#pragma unroll
                for (int d = 0; d < NDB; ++d)
#pragma unroll
                    for (int r = 0; r < 16; ++r) { const float x = o[d][r] * inv - lam_full * xch[(d * 16 + r) * 64]; o[d][r] = x; ss += x * x; }
                ss = xhalf_sum(ss);
                const float rs = rsqrtf(ss * (1.f / 128.f) + EPS) * (1.f - lam_init);
#pragma unroll
                for (int d = 0; d < NDB; ++d)
#pragma unroll
                    for (int j = 0; j < 2; ++j) { u32x2 pc[2];
#pragma unroll
                        for (int k = 0; k < 2; ++k) { const int rq = 2 * j + k, dc = 32 * d + 8 * rq + 4 * hi; const f32x4 gn = *(const f32x4*)(subln + dc);
                            f32x4 x; x[0] = o[d][4 * rq] * rs * gn[0]; x[1] = o[d][4 * rq + 1] * rs * gn[1]; x[2] = o[d][4 * rq + 2] * rs * gn[2]; x[3] = o[d][4 * rq + 3] * rs * gn[3]; pc[k] = pack4(x); }
                        *(u32x4*)(orow + 32 * d + 16 * j + 8 * hi) = pair_swap(pc[0], pc[1]); }
            }
            __syncthreads();
        } else {
#pragma unroll
            for (int d = 0; d < NDB; ++d)
#pragma unroll
                for (int j = 0; j < 2; ++j) { u32x2 pc[2];
#pragma unroll
                    for (int k = 0; k < 2; ++k) { const int rq = 2 * j + k;
                        f32x4 x; x[0] = o[d][4 * rq] * inv; x[1] = o[d][4 * rq + 1] * inv; x[2] = o[d][4 * rq + 2] * inv; x[3] = o[d][4 * rq + 3] * inv; pc[k] = pack4(x); }
                    *(u32x4*)(orow + 32 * d + 16 * j + 8 * hi) = pair_swap(pc[0], pc[1]); }
        }
    }
}
#define XB_TMO      128
#define XB_XCNT(j)  (256  + 64 * (j))
#define XB_XSUB(j)  (1280 + 64 * (j))
#define XB_XGEN(j)  (2304 + 64 * (j))
#define XB_TOP      3328
#define XB_TOPGEN   3392
#define XCD_BAR_WORDS 3456
#define XB_SPIN_CAP (1u << 18)

__device__ __forceinline__ unsigned xb_ld(unsigned* p)              { return __hip_atomic_load(p, __ATOMIC_RELAXED, __HIP_MEMORY_SCOPE_AGENT); }
__device__ __forceinline__ unsigned xb_add(unsigned* p, unsigned v) { return __hip_atomic_fetch_add(p, v, __ATOMIC_RELAXED, __HIP_MEMORY_SCOPE_AGENT); }
__device__ __forceinline__ unsigned xb_xcc_id() { return (unsigned)__builtin_amdgcn_s_getreg((3 << 11) | 20) & 0xFu; }
#define XB_SPIN(cond, bar) do { unsigned _sp = 0; while (cond) { __builtin_amdgcn_s_sleep(1); \
    if ((++_sp & 255u) == 0u) { if (xb_ld(&(bar)[XB_TMO])) break; if (_sp > XB_SPIN_CAP) { atomicAdd(&(bar)[XB_TMO], 1u); break; } } } } while (0)

struct XcdBarrier {
    unsigned* bar; unsigned x;
    volatile LAS unsigned* st;
};

__device__ __forceinline__ XcdBarrier xcd_barrier_post(unsigned* bar, volatile LAS unsigned* st) {
    XcdBarrier b; b.bar = bar; b.x = xb_xcc_id(); b.st = st;
    if (tidx() == 0) (void)xb_add(&bar[XB_XCNT(b.x)], 1u);
    return b;
}
__device__ __forceinline__ void xcd_barrier_complete(unsigned* bar, unsigned x, unsigned& nloc, unsigned& nx) {
    const unsigned G = gridDim.x * gridDim.y * gridDim.z;
    unsigned sum, cnt, mine, sp = 0u;
    for (;;) {
        sum = 0u; cnt = 0u; mine = 0u;
#pragma unroll
        for (unsigned j = 0; j < 16; ++j) { const unsigned c = xb_ld(&bar[XB_XCNT(j)]); sum += c; cnt += (c > 0u) ? 1u : 0u; mine = (j == x) ? c : mine; }
        if (sum == G) break;
        __builtin_amdgcn_s_sleep(1);
        if ((++sp & 255u) == 0u) { if (xb_ld(&bar[XB_TMO])) break; if (sp > XB_SPIN_CAP) { atomicAdd(&bar[XB_TMO], 1u); break; } }
    }
    nloc = mine > 0u ? mine : 1u; nx = cnt > 0u ? cnt : 1u;
}

__device__ __forceinline__ void xcd_barrier(const XcdBarrier& b) {
    asm volatile("s_waitcnt vmcnt(0)" ::: "memory");
    __syncthreads();
    if (tidx() == 0) {
        unsigned* bar = b.bar;
        __builtin_amdgcn_s_waitcnt(0);
        unsigned nloc = b.st[0], nx = b.st[1];
        if (nloc == 0u) { xcd_barrier_complete(bar, b.x, nloc, nx); b.st[0] = nloc; b.st[1] = nx; }
        const unsigned old = xb_add(&bar[XB_XSUB(b.x)], 1u);
        const unsigned gen = old / nloc;
        if (old + 1u == (gen + 1u) * nloc) {
            __builtin_amdgcn_fence(__ATOMIC_RELEASE, "agent");
            asm volatile("s_waitcnt vmcnt(0)" ::: "memory");
            const unsigned og = xb_add(&bar[XB_TOP], 1u);
            const unsigned tg = og / nx;
            if (og + 1u == (tg + 1u) * nx) xb_add(&bar[XB_TOPGEN], 1u);
            else XB_SPIN(xb_ld(&bar[XB_TOPGEN]) == tg, bar);
            __builtin_amdgcn_fence(__ATOMIC_ACQUIRE, "agent");
            xb_add(&bar[XB_XGEN(b.x)], 1u);
            asm volatile("s_waitcnt vmcnt(0)" ::: "memory");
        } else {
            XB_SPIN(xb_ld(&bar[XB_XGEN(b.x)]) == gen, bar);
            __builtin_amdgcn_fence(__ATOMIC_ACQUIRE, "agent");
            asm volatile("s_waitcnt vmcnt(0)" ::: "memory");
        }
    }
    __syncthreads();
}

__device__ __forceinline__ void rms_rows_bf16(const float* src, const float* gain, bf16_t* dst) {
    int tid_ = tidx();
    const int lane = tid_ & 63, gw = bidx() * 8 + (tid_ >> 6), ngw = gdim() * 8;
    f32x4 gn[4];
#pragma unroll
    for (int j = 0; j < 4; ++j) gn[j] = ((const f32x4*)gain)[lane + 64 * j];
    for (int m = gw; m < T; m += ngw) {
        const f32x4* xr = (const f32x4*)(src + (size_t)m * DM) + lane; f32x4 v[4]; float ss = 0.f;
#pragma unroll
        for (int j = 0; j < 4; ++j) { v[j] = xr[64 * j]; ss += (v[j][0] * v[j][0] + v[j][1] * v[j][1]) + (v[j][2] * v[j][2] + v[j][3] * v[j][3]); }
        const float rs = rsqrtf(wave_sum(ss, lane) * (1.f / DM) + EPS);
        u32x2* o = (u32x2*)(dst + (size_t)m * DM) + lane;
#pragma unroll
        for (int j = 0; j < 4; ++j) o[64 * j] = pack4(v[j] * rs * gn[j]);
    }
}
__device__ __forceinline__ void x_rows_prep(const float* src, bf16_t* dst, float* SS) {
    int tid_ = tidx();
    const int lane = tid_ & 63, gw = bidx() * 8 + (tid_ >> 6), ngw = gdim() * 8;
    for (int m = 2 * gw; m < T; m += 2 * ngw) {
        const f32x4* xa = (const f32x4*)(src + (size_t)m * DM) + lane; const f32x4* xb = xa + DM / 4; f32x4 va[4], vb[4]; float sa = 0.f, sb = 0.f;
#pragma unroll
        for (int j = 0; j < 4; ++j) { va[j] = xa[64 * j]; vb[j] = xb[64 * j]; }
#pragma unroll
        for (int j = 0; j < 4; ++j) { sa += (va[j][0] * va[j][0] + va[j][1] * va[j][1]) + (va[j][2] * va[j][2] + va[j][3] * va[j][3]); sb += (vb[j][0] * vb[j][0] + vb[j][1] * vb[j][1]) + (vb[j][2] * vb[j][2] + vb[j][3] * vb[j][3]); }
        sa = wave_sum(sa, lane); sb = wave_sum(sb, lane);
        u32x2* oa = (u32x2*)(dst + (size_t)m * DM) + lane; u32x2* ob = oa + DM / 4;
#pragma unroll
        for (int j = 0; j < 4; ++j) { oa[64 * j] = pack4(va[j]); ob[64 * j] = pack4(vb[j]); }
        if (lane < 32) SS[(size_t)m * 16 + lane] = lane == 0 ? sa : lane == 16 ? sb : 0.f;
    }
}
__device__ __forceinline__ void rms_rows_final(const bf16_t* HB, const bf16_t* LO, const float* gain, float* dst) {
    int tid_ = tidx();
    const int lane = tid_ & 63, gw = bidx() * 8 + (tid_ >> 6), ngw = gdim() * 8;
    for (int m = 2 * gw; m < T; m += 2 * ngw) {
        f32x4 v[2][4]; float ss[2] = {0.f, 0.f};
#pragma unroll
        for (int r = 0; r < 2; ++r) { const u32x4* hr = (const u32x4*)(HB + (size_t)(m + r) * DM) + lane; const u32x4* lr = (const u32x4*)(LO + (size_t)(m + r) * DM) + lane;
#pragma unroll
            for (int j = 0; j < 2; ++j) { f32x4 a0, a1, l0, l1; unpack8(hr[64 * j], a0, a1); unpack8(lr[64 * j], l0, l1); v[r][2 * j] = a0 + l0; v[r][2 * j + 1] = a1 + l1; } }
#pragma unroll
        for (int r = 0; r < 2; ++r)
#pragma unroll
            for (int j = 0; j < 4; ++j) ss[r] += (v[r][j][0] * v[r][j][0] + v[r][j][1] * v[r][j][1]) + (v[r][j][2] * v[r][j][2] + v[r][j][3] * v[r][j][3]);
#pragma unroll
        for (int r = 0; r < 2; ++r) { const float rs = rsqrtf(wave_sum(ss[r], lane) * (1.f / DM) + EPS);
#pragma unroll
            for (int j = 0; j < 2; ++j) { const f32x4* gp = (const f32x4*)(gain + 512 * j + 8 * lane); f32x4* o = (f32x4*)(dst + (size_t)(m + r) * DM + 512 * j + 8 * lane);
                o[0] = v[r][2 * j] * rs * gp[0]; o[1] = v[r][2 * j + 1] * rs * gp[1]; } }
    }
}
__device__ __forceinline__ void cvt_rows_bf16(const float* src, bf16_t* dst, size_t nquads) {
    const size_t gs_ = (size_t)gdim() * 512;
    for (size_t i = (size_t)bidx() * 512 + tidx(); i < nquads; i += 4 * gs_) {
        f32x4 v[4];
#pragma unroll
        for (int k = 0; k < 4; ++k) if (i + k * gs_ < nquads) v[k] = ((const f32x4*)src)[i + k * gs_];
#pragma unroll
        for (int k = 0; k < 4; ++k) if (i + k * gs_ < nquads) ((u32x2*)dst)[i + k * gs_] = pack4(v[k]);
    }
}
template <int MAP> __device__ __forceinline__ int colmap(int g, int lim) {
    if (MAP == 1) { if (g >= lim) return g; const int tl = g >> 8, bj = (g >> 7) & 1, hw = (g >> 5) & 3, i = g & 31; return 256 * tl + 64 * hw + 32 * bj + i; }
    if (MAP == 2) { const int pn = g >> 8, bj = (g >> 7) & 1, j = g & 127; return bj * DFF + 128 * pn + j; }
    return g;
}
template <int MAP> __device__ __forceinline__ void convert_w(const float* src, const float* gain, int K, int N, bf16_t* dst, int lim, LAS float* scr, int& it, int& base) {
    int tid_ = tidx();
    const int tid = tid_, ntn = N / 256, ntiles = (K / 64) * ntn, G = gdim();
    for (; it < base + ntiles; it += G) {
        const int tile = it - base, k0 = (tile / ntn) * 64, g0 = (tile % ntn) * 256;
        { const int kk = tid >> 8, gg = tid & 255, sc = colmap<MAP>(g0 + gg, lim); float v[32];
#pragma unroll
          for (int i = 0; i < 32; ++i) v[i] = src[(size_t)(k0 + kk + 2 * i) * N + sc];
#pragma unroll
          for (int i = 0; i < 32; ++i) scr[(kk + 2 * i) * 257 + gg] = v[i] * (gain ? gain[k0 + kk + 2 * i] : 1.f); }
        __syncthreads();
#pragma unroll
        for (int j = 0; j < 4; ++j) { const int g = (tid >> 3) + 64 * j, kc = tid & 7; const LAS float* s = scr + (kc * 8) * 257 + g; u32x4 w;
          w.x = pg8::cvt_pk_bf16(s[0], s[257]); w.y = pg8::cvt_pk_bf16(s[2 * 257], s[3 * 257]); w.z = pg8::cvt_pk_bf16(s[4 * 257], s[5 * 257]); w.w = pg8::cvt_pk_bf16(s[6 * 257], s[7 * 257]);
          *(u32x4*)(dst + (size_t)(g0 + g) * K + k0 + kc * 8) = w; }
        __syncthreads();
    }
    base += ntiles;
}
__device__ __forceinline__ void rope_table(const int* pos, float* cosT, float* sinT) {
    const int gs_ = gdim() * 512;
    for (int idx = bidx() * 512 + tidx(); idx < T * 32; idx += gs_) {
        const int tok = idx >> 5, i = idx & 31;
        const float inv = exp2f(-(float)i * 0.41524101186092029f);
        const float ang = (float)pos[tok] * inv;
        const float n = rintf(ang * 0.6366197723675814f);
        float r = fmaf(n, -1.5703125f, ang); r = fmaf(n, -4.837512969970703125e-4f, r); r = fmaf(n, -7.54978995489188216e-8f, r);
        const float s = __sinf(r), c = __cosf(r); const int q = (int)n & 3;
        cosT[idx] = q == 0 ? c : q == 1 ? -s : q == 2 ? -c : s;
        sinT[idx] = q == 0 ? s : q == 1 ? c : q == 2 ? -s : -c;
    }
}

#ifndef NRUN
#define NRUN NPHASE
#endif
#ifndef PHMASK
#define PHMASK 0x7F
#endif
struct Params { const float* in[20]; float* out; unsigned char* ws; int lo, hi; };
enum { I_X = 0, I_P, I_POS, I_ATTN_NORM, I_FFN_NORM, I_PLE_NORM, I_FINAL_NORM, I_DIFF_QKV, I_DIFF_O, I_DIFF_LAM, I_DIFF_SUBLN, I_SWA_QKV, I_SWA_O, I_SWA_SINKS, I_UP, I_CONV_W, I_CONV_B, I_DOWN, I_PLE_PROJ, I_PLE_GATE };

template <class Epi> __device__ __forceinline__ void run_gemm(LAS unsigned char* lds, const bf16_t* A, const bf16_t* Bt, int N, int K, const Epi& E) {
    pg8::Gemm g{A, Bt, T, N, K}; pg8::StaticOrder S; S.init(T, N, gdim(), bidx());
    pg8::gemm_phase<Epi, pg8::StaticOrder, true, true>(lds, g, S, E);
}

__global__ void __launch_bounds__(512, 2) fwd_kernel(Params P) {
    extern __shared__ __attribute__((aligned(16))) unsigned char lds_raw[];
    LAS unsigned char* lds = (LAS unsigned char*)lds_raw;
#ifdef PROBE_DUP
#ifndef PROBE_LMASK
#define PROBE_LMASK 15
#endif
    int dup_done_ = 0;
#endif
    volatile LAS unsigned* xst = (volatile LAS unsigned*)(lds + 131072);
    if (threadIdx.x < 4) xst[threadIdx.x] = 0u;
    if ((threadIdx.x & 63) == 0) *reinterpret_cast<volatile LAS int*>(TID_TBL + 4u * hw_wave_slot()) = (int)(threadIdx.x >> 6);
    __syncthreads();
    XcdBarrier xbar = xcd_barrier_post((unsigned*)(P.ws + WS_BAR), xst);
    for (int ph = P.lo; ph < P.hi; ++ph) {
        int zz = 0; asm volatile("" : "+s"(zz));
        unsigned char* ws = P.ws + zz;
        bf16_t* XN = (bf16_t*)(ws + WS_XN); bf16_t* Qb = (bf16_t*)(ws + WS_Q); bf16_t* Kb = (bf16_t*)(ws + WS_K); bf16_t* Vb = (bf16_t*)(ws + WS_V);
        bf16_t* Ob = (bf16_t*)(ws + WS_O); bf16_t* Gb = (bf16_t*)(ws + WS_G); bf16_t* ACT = (bf16_t*)(ws + WS_ACT); bf16_t* HALO = (bf16_t*)(ws + WS_HALO); bf16_t* PB = (bf16_t*)(ws + WS_PB);
        float* cosT = (float*)(ws + WS_COS); float* sinT = (float*)(ws + WS_SIN);
        bf16_t* LOb = (bf16_t*)(ws + WS_LO);
        float* SS = (float*)(ws + WS_SS);
        if (ph == 0) {
            int it = bidx(), base = 0; LAS float* scr = (LAS float*)lds;
            for (int L = 0; L < DEPTH; ++L) {
                unsigned char* wl = ws + WS_W + (size_t)L * W_LAYER; const int j = L >> 1;
                if ((L & 1) == 0) { convert_w<1>(P.in[zz + I_DIFF_QKV] + (size_t)j * DM * 3072, P.in[zz + I_ATTN_NORM] + L * DM, DM, 3072, (bf16_t*)(wl + W_QKV), 2048, scr, it, base);
                                    convert_w<0>(P.in[zz + I_DIFF_O] + (size_t)j * DM * DM, nullptr, DM, DM, (bf16_t*)(wl + W_O), 0, scr, it, base); }
                else { convert_w<1>(P.in[zz + I_SWA_QKV] + (size_t)j * DM * 1536, P.in[zz + I_ATTN_NORM] + L * DM, DM, 1536, (bf16_t*)(wl + W_QKV), 1280, scr, it, base);
                       convert_w<0>(P.in[zz + I_SWA_O] + (size_t)j * DM * DM, nullptr, DM, DM, (bf16_t*)(wl + W_O), 0, scr, it, base); }
                convert_w<2>(P.in[zz + I_UP] + (size_t)L * DM * 2 * DFF, P.in[zz + I_FFN_NORM] + L * DM, DM, 2 * DFF, (bf16_t*)(wl + W_UP), 0, scr, it, base);
                convert_w<0>(P.in[zz + I_DOWN] + (size_t)L * DFF * DM, nullptr, DFF, DM, (bf16_t*)(wl + W_DOWN), 0, scr, it, base);
                convert_w<0>(P.in[zz + I_PLE_GATE] + (size_t)L * DM * DM, P.in[zz + I_PLE_NORM] + L * DM, DM, DM, (bf16_t*)(wl + W_GATE), 0, scr, it, base);
                convert_w<0>(P.in[zz + I_PLE_PROJ] + (size_t)L * PLE * DM, nullptr, PLE, DM, (bf16_t*)(wl + W_PROJ), 0, scr, it, base);
            }
            rope_table((const int*)P.in[zz + I_POS], cosT, sinT);
            x_rows_prep(P.in[zz + I_X], XN, SS);
        } else if (ph == NPHASE - 1) {
            rms_rows_final(XN, LOb, P.in[zz + I_FINAL_NORM], P.out + zz);
        } else {
            const int L = (ph - 1) / 7, k = (ph - 1) % 7, j = L >> 1; const bool diff = (L & 1) == 0;
            unsigned char* wl = ws + WS_W + (size_t)L * W_LAYER;
            const float lam_init = L == 0 ? 0.2f : 0.47071301834f;
            if (k == 0 && (PHMASK >> 0 & 1)) {
                if (diff) { EpiQKV E{Qb, Kb, Vb, 4, 4, 1024, 1024, cosT, sinT, 0.125f * LOG2E, SS}; run_gemm(lds, XN, (const bf16_t*)(wl + W_QKV), 3072, DM, E); }
                else { EpiQKV E{Qb, Kb, Vb, 4, 1, 256, 256, cosT, sinT, 0.125f * LOG2E, SS}; run_gemm(lds, XN, (const bf16_t*)(wl + W_QKV), 1536, DM, E); }
            } else if (k == 1 && (PHMASK >> 1 & 1)) {
                if (diff) attn_phase<true>(lds, Qb, Kb, Vb, Ob, P.in[zz + I_DIFF_LAM] + j * 256, P.in[zz + I_DIFF_SUBLN] + j * 128, lam_init);
                else attn_phase<false>(lds, Qb, Kb, Vb, Ob, P.in[zz + I_SWA_SINKS] + j * 16, nullptr, 0.f);
            } else if (k == 2 && (PHMASK >> 2 & 1)) {
                if (L == 0) { EpiRes<true> E{P.in[zz + I_X], XN, LOb, SS}; run_gemm(lds, Ob, (const bf16_t*)(wl + W_O), DM, DM, E); }
                else { EpiRes<false> E{nullptr, XN, LOb, SS}; run_gemm(lds, Ob, (const bf16_t*)(wl + W_O), DM, DM, E); }
            } else if (k == 3 && (PHMASK >> 3 & 1)) {
                EpiUp E{ACT, HALO, P.in[zz + I_CONV_W] + (size_t)L * 6 * DFF, P.in[zz + I_CONV_B] + (size_t)L * 2 * DFF, SS}; run_gemm(lds, XN, (const bf16_t*)(wl + W_UP), 2 * DFF, DM, E);
            } else if (k == 4 && (PHMASK >> 4 & 1)) {
                { pg8::StaticOrder S; S.init(T, DM, gdim(), bidx()); Unit u; int last_pm = -1;
                  for (int i = 0; S.next(i, u); ++i) if (u.pm != last_pm) { ffn_fixup_panel(HALO, ACT, P.in[zz + I_CONV_W] + (size_t)L * 6 * DFF, P.in[zz + I_CONV_B] + (size_t)L * 2 * DFF, u.pm); last_pm = u.pm; } }
                cvt_rows_bf16(P.in[zz + I_P] + (size_t)L * T * PLE, PB, (size_t)T * PLE / 4);
                asm volatile("s_waitcnt vmcnt(0)" ::: "memory"); __syncthreads();
                EpiRes<false> E{nullptr, XN, LOb, SS}; run_gemm(lds, ACT, (const bf16_t*)(wl + W_DOWN), DM, DFF, E);
            } else if (k == 5 && (PHMASK >> 5 & 1)) {
                EpiGate E{Gb, SS}; run_gemm(lds, XN, (const bf16_t*)(wl + W_GATE), DM, DM, E);
            } else if (PHMASK >> 6 & 1) {
                EpiProj E{Gb, XN, LOb, SS}; run_gemm(lds, PB, (const bf16_t*)(wl + W_PROJ), DM, PLE, E);
            }
        }
#ifdef PROBE_DUP
        if (((ph == 0 && (PROBE_DUP & 0x100)) || (ph > 0 && ph < NPHASE - 1 && ((PROBE_DUP >> ((ph - 1) % 7)) & 1) && ((PROBE_LMASK >> ((ph - 1) / 7)) & 1))) && !(dup_done_)) { dup_done_ = 1; xcd_barrier(xbar); --ph; continue; }
        dup_done_ = 0;
#endif
        if (ph + 1 < P.hi) xcd_barrier(xbar); else if (ph + 1 > NPHASE) cg::this_grid().sync();
    }
}

extern "C" void kernel_launch(void* const* d_in, const int* in_sizes, int n_in, void* d_out, int out_size, void* d_ws, size_t ws_size, hipStream_t stream) {
    static int grid = 0;
    if (grid == 0) {
        if (n_in != 20 || out_size != T * DM || ws_size < WS_END) { fprintf(stderr, "kernel_launch: unexpected shapes: n_in %d out %d ws %zu\n", n_in, out_size, ws_size); grid = -1; return; }
        int dev = 0, cus = 0, per_cu = 0;
        hipGetDevice(&dev); hipDeviceGetAttribute(&cus, hipDeviceAttributeMultiprocessorCount, dev);
        hipFuncSetAttribute((const void*)fwd_kernel, hipFuncAttributeMaxDynamicSharedMemorySize, LDS_BYTES);
        hipOccupancyMaxActiveBlocksPerMultiprocessor(&per_cu, (const void*)fwd_kernel, 512, LDS_BYTES);
        if (per_cu < 1) { fprintf(stderr, "kernel_launch: occupancy query says %d blocks per CU\n", per_cu); per_cu = 1; }
        (void)hipGetLastError();
        grid = cus * per_cu;
    }
    if (grid < 0) return;
    if (hipMemsetAsync((char*)d_ws + WS_BAR, 0, XCD_BAR_WORDS * 4, stream) != hipSuccess) { fprintf(stderr, "kernel_launch: hipMemsetAsync of the barrier words failed\n"); return; }
    Params P{};
    for (int i = 0; i < 20; ++i) P.in[i] = (const float*)d_in[i];
    P.out = (float*)d_out; P.ws = (unsigned char*)d_ws;
#if MK_ONE_LAUNCH
    P.lo = 0; P.hi = NPHASE;
    void* args[] = {&P};
    hipError_t e = hipLaunchCooperativeKernel((const void*)fwd_kernel, dim3(grid), dim3(512), args, LDS_BYTES, stream);
    if (e != hipSuccess) fprintf(stderr, "cooperative launch failed: %s (grid %d)\n", hipGetErrorString(e), grid);
#else
    for (int ph = 0; ph < NRUN; ++ph) { P.lo = ph; P.hi = ph + 1; hipLaunchKernelGGL(fwd_kernel, dim3(grid), dim3(512), LDS_BYTES, stream, P); }
#endif
}
```
